# Optimizing an MI355X kernel written in HIP

```python
import jax, jax.numpy as jnp
from jax import lax
import numpy as np

D_MODEL = 1024
BATCH = 2
SEQ = 8192
DEPTH = 4

HEAD_DIM = 64
N_Q_HEADS = D_MODEL // (2 * HEAD_DIM)
N_KV_HEADS = max(1, N_Q_HEADS // 4)
GQA_GROUP = N_Q_HEADS // N_KV_HEADS
WINDOW = 128
ATTN_BLOCK = 128
GM_HEADS = N_Q_HEADS
GM_HEAD_DIM = HEAD_DIM
CHUNK = 128
ATTN_W = N_Q_HEADS * HEAD_DIM
KV_W = N_KV_HEADS * HEAD_DIM
GM_W = GM_HEADS * GM_HEAD_DIM
D_MIX = ATTN_W + GM_W
D_IN = ATTN_W + 2 * KV_W + 2 * GM_W
D_FF = ((8 * D_MODEL + 3 * 256 - 1) // (3 * 256)) * 256
PLE_DIM = 256
NORM_EPS = 1e-6
NEG_BIG = -1e30

kernel_name = "hymba_swa_gmlp_hybrid"


def rmsnorm(x, g):
    xf = x.astype(jnp.float32)
    y = xf * lax.rsqrt(jnp.mean(xf * xf, axis=-1, keepdims=True) + NORM_EPS)
    return (y * g.astype(jnp.float32)).astype(x.dtype)


def layernorm(x, g, b):
    xf = x.astype(jnp.float32)
    mu = jnp.mean(xf, axis=-1, keepdims=True)
    xc = xf - mu
    y = xc * lax.rsqrt(jnp.mean(xc * xc, axis=-1, keepdims=True) + NORM_EPS)
    return (y * g.astype(jnp.float32) + b.astype(jnp.float32)).astype(x.dtype)


def alibi_slopes(n_heads):
    return jnp.exp2(-8.0 * (jnp.arange(n_heads, dtype=jnp.float32) + 1.0) / n_heads)


def sliding_window_attention(q, k, v, sinks):
    B, S = q.shape[0], q.shape[1]
    nb = S // ATTN_BLOCK
    qb = q.reshape(B, nb, ATTN_BLOCK, N_KV_HEADS, GQA_GROUP, HEAD_DIM)
    kb = k.reshape(B, nb, ATTN_BLOCK, N_KV_HEADS, HEAD_DIM)
    vb = v.reshape(B, nb, ATTN_BLOCK, N_KV_HEADS, HEAD_DIM)
    pad = ((0, 0), (1, 0), (0, 0), (0, 0), (0, 0))
    kk = jnp.concatenate([jnp.pad(kb[:, :-1], pad), kb], axis=2)
    vv = jnp.concatenate([jnp.pad(vb[:, :-1], pad), vb], axis=2)
    scale = HEAD_DIM ** -0.5
    s = jnp.einsum('bnqkgd,bnskd->bnkgqs', qb, kk,
                   preferred_element_type=jnp.float32) * scale
    qi = jnp.arange(ATTN_BLOCK)[:, None]
    kj = jnp.arange(2 * ATTN_BLOCK)[None, :]
    dist = qi + ATTN_BLOCK - kj
    band = (dist >= 0) & (dist < WINDOW)
    blk = jnp.arange(nb)[:, None, None]
    valid = band[None] & ((blk > 0) | (kj >= ATTN_BLOCK)[None])
    slopes = alibi_slopes(N_Q_HEADS).reshape(N_KV_HEADS, GQA_GROUP)
    bias = -slopes[:, :, None, None] * dist.astype(jnp.float32)
    s = jnp.where(valid[None, :, None, None], s + bias[None, None], NEG_BIG)
    sink = sinks.astype(jnp.float32).reshape(N_KV_HEADS, GQA_GROUP)[None, None, :, :, None, None]
    m = jnp.maximum(jnp.max(s, axis=-1, keepdims=True), sink)
    e = jnp.exp(s - m)
    pr = e / (jnp.sum(e, axis=-1, keepdims=True) + jnp.exp(sink - m))
    o = jnp.einsum('bnkgqs,bnskd->bnqkgd', pr.astype(vv.dtype), vv)
    return o.reshape(B, S, ATTN_W)


def chunked_spatial_gating(zu, zv, ln_g, ln_b, ws, bs):
    B, S = zu.shape[0], zu.shape[1]
    nc = S // CHUNK
    zv = layernorm(zv, ln_g, ln_b)
    vh = zv.reshape(B, nc, CHUNK, GM_HEADS, GM_HEAD_DIM)
    causal = jnp.tril(jnp.ones((CHUNK, CHUNK), dtype=bool))
    w = jnp.where(causal[None], ws, jnp.zeros_like(ws))
    mixed = jnp.einsum('hts,bnshc->bnthc', w, vh) + bs.T[None, None, :, :, None]
    return zu * mixed.reshape(B, S, GM_W)


def setup_inputs(seed: int = 0) -> dict:
    key = jax.random.key(seed)
    ks = jax.random.split(key, 24)
    f32 = jnp.float32
    nrm = lambda k, shape, s: jax.random.normal(k, shape, f32) * s
    gain = lambda k, n: 1.0 + 0.05 * jax.random.normal(k, (DEPTH, n), f32)
    return {
        "x": nrm(ks[0], (BATCH, SEQ, D_MODEL), 1.0),
        "p": nrm(ks[1], (DEPTH, BATCH, SEQ, PLE_DIM), 1.0),
        "ln_mix_pre": gain(ks[2], D_MODEL),
        "w_in": nrm(ks[3], (DEPTH, D_MODEL, D_IN), D_MODEL ** -0.5),
        "attn_sinks": nrm(ks[4], (DEPTH, N_Q_HEADS), 1.0),
        "gm_ln_g": gain(ks[5], GM_W),
        "gm_ln_b": nrm(ks[6], (DEPTH, GM_W), 0.01),
        "gm_ws": nrm(ks[7], (DEPTH, GM_HEADS, CHUNK, CHUNK), CHUNK ** -0.5),
        "gm_bs": 1.0 + nrm(ks[8], (DEPTH, GM_HEADS, CHUNK), 0.01),
        "g_attn_out": gain(ks[9], ATTN_W),
        "g_gm_out": gain(ks[10], GM_W),
        "w_out": nrm(ks[11], (DEPTH, D_MIX, D_MODEL), D_MIX ** -0.5),
        "ln_mix_post": gain(ks[12], D_MODEL),
        "ln_ffn_pre": gain(ks[13], D_MODEL),
        "w_ffn_gate": nrm(ks[14], (DEPTH, D_MODEL, D_FF), D_MODEL ** -0.5),
        "w_ffn_up": nrm(ks[15], (DEPTH, D_MODEL, D_FF), D_MODEL ** -0.5),
        "w_ffn_down": nrm(ks[16], (DEPTH, D_FF, D_MODEL), D_FF ** -0.5),
        "ln_ffn_post": gain(ks[17], D_MODEL),
        "w_ple": nrm(ks[18], (DEPTH, PLE_DIM, D_MODEL), PLE_DIM ** -0.5),
        "ln_ple_gate": gain(ks[19], D_MODEL),
        "w_ple_gate": nrm(ks[20], (DEPTH, D_MODEL, D_MODEL), D_MODEL ** -0.5),
    }


def reference(x, p, ln_mix_pre, w_in, attn_sinks, gm_ln_g, gm_ln_b, gm_ws, gm_bs,
              g_attn_out, g_gm_out, w_out, ln_mix_post, ln_ffn_pre, w_ffn_gate,
              w_ffn_up, w_ffn_down, ln_ffn_post, w_ple, ln_ple_gate, w_ple_gate):
    h = x
    splits = [ATTN_W, ATTN_W + KV_W, ATTN_W + 2 * KV_W, ATTN_W + 2 * KV_W + GM_W]
    for i in range(DEPTH):
        a = rmsnorm(h, ln_mix_pre[i])
        z = a @ w_in[i]
        q, k, v, zu, zv = jnp.split(z, splits, axis=-1)
        attn = sliding_window_attention(q, k, v, attn_sinks[i])
        gm = chunked_spatial_gating(jax.nn.gelu(zu), jax.nn.gelu(zv),
                                    gm_ln_g[i], gm_ln_b[i], gm_ws[i], gm_bs[i])
        heads = jnp.concatenate([rmsnorm(attn, g_attn_out[i]),
                                 rmsnorm(gm, g_gm_out[i])], axis=-1)
        h = h + rmsnorm(heads @ w_out[i], ln_mix_post[i])
        f = rmsnorm(h, ln_ffn_pre[i])
        f = (jax.nn.silu(f @ w_ffn_gate[i]) * (f @ w_ffn_up[i])) @ w_ffn_down[i]
        h = h + rmsnorm(f, ln_ffn_post[i])
        gate = jax.nn.sigmoid(rmsnorm(h, ln_ple_gate[i]) @ w_ple_gate[i])
        h = h + (p[i] @ w_ple[i]) * gate
    return h
```

```cpp
#include <hip/hip_runtime.h>
#include <hip/hip_cooperative_groups.h>
#include <cstdio>
#include <cstdint>
namespace cg = cooperative_groups;
namespace pg8 {
#define PG8_LAS __attribute__((address_space(3)))
typedef unsigned short bf16_t;
typedef short bf16x8 __attribute__((ext_vector_type(8)));
typedef float f32x4 __attribute__((ext_vector_type(4)));
typedef unsigned u32x4 __attribute__((ext_vector_type(4)));
constexpr int BM = 256, BK = 64, HALF = 128, HTB = HALF * BK * 2  , STAGE_BYTES = 8 * HTB, NXCD = 8, WGM = 8;

__host__ __device__ __forceinline__ int lds_byte(int r, int c) { const int st = (r >> 4) * 2 + (c >> 5), rr = r & 15, cc = c & 31, ob = rr * 64 + cc * 2; return st * 1024 + (ob ^ (((ob >> 9) & 1) << 5)); }
__host__ __device__ __forceinline__ void stage_rc(int b, int& R, int& C) { const int st = b / 1024, sb = b % 1024, swz = sb ^ (((sb >> 9) & 1) << 5); R = (st >> 1) * 16 + swz / 64; C = (st & 1) * 32 + (swz % 64) / 2; }
__host__ __device__ __forceinline__ int perm32(int rho) { const int n = rho >> 4, i = rho & 15; return 8 * (i >> 2) + 4 * n + (i & 3); }

struct Unit { int pm, pn; };
struct Gemm { const bf16_t* A; const bf16_t* Bt; int M, N, K; };

struct StaticOrder {
    int nM, nN, nwg, G, c;
    __host__ __device__ void init(int M, int N, int G_, int c_) { nM = M / BM; nN = N / BM; nwg = nM * nN; G = G_; c = c_; }
    __host__ __device__ bool next(int i, Unit& u) const {
        const long L = (long)i * G + c; if (L >= nwg) return false;
        int wgid = (int)L; { const int q = nwg / NXCD, r = nwg % NXCD, xcd = wgid % NXCD, off = wgid / NXCD; wgid = (xcd < r ? xcd * (q + 1) : r * (q + 1) + (xcd - r) * q) + off; }
        const int nig = WGM * nN, gid = wgid / nig, fm = gid * WGM, gsz = (nM - fm) < WGM ? (nM - fm) : WGM;
        u.pm = fm + ((wgid % nig) % gsz); u.pn = (wgid % nig) / gsz; return true;
    }
    __device__ __forceinline__ void a_ready(const Unit&) const {}
    __device__ __forceinline__ void done(const Unit&) const {}
};

__device__ __forceinline__ unsigned cvt_pk_bf16(float lo, float hi) { unsigned r; asm volatile("v_cvt_pk_bf16_f32 %0, %1, %2" : "=v"(r) : "v"(lo), "v"(hi)); return r; }
typedef float f32x2 __attribute__((ext_vector_type(2)));
__device__ __forceinline__ f32x2 gelu_pk(f32x2 v) {
    const f32x2 av = __builtin_elementwise_abs(v), d = av * 0.2316418882f + 1.0f;
    f32x2 t; t.x = __builtin_amdgcn_rcpf(d.x); t.y = __builtin_amdgcn_rcpf(d.y);
    f32x2 q = t * 0.5307027145f + (-0.7265760135f); q = q * t + 0.7107068705f; q = q * t + (-0.142248368f); q = q * t + 0.127414796f; q = q * t;
    const f32x2 s = (v * v) * (-0.72134752044f);
    f32x2 e; e.x = __builtin_amdgcn_exp2f(s.x); e.y = __builtin_amdgcn_exp2f(s.y);
    const f32x2 m = v * (q * e), r = v - m;
    f32x2 o; o.x = v.x < 0.f ? m.x : r.x; o.y = v.y < 0.f ? m.y : r.y; return o;
}

template <int ACT  > struct EpiBf16 {
    static constexpr bool PERM = true, AFTER_DRAIN = false; static_assert(ACT == 0 || ACT == 1, "EpiBf16: ACT is 0 (none) or 1 (gelu_pk)");
    bf16_t* O; int ldc; const float* bias; int split_cols; size_t split_stride; float scale0;
    __device__ __forceinline__ void operator()(const f32x4 (&acc)[2][2][4][2], const Unit& u, int wr, int wc, int fr, int fq) const {
        const int row0 = u.pm * BM + wr * 64 + fr; int colt = u.pn * BM; bf16_t* base = O;
        float sc = 1.f; if (split_cols) { const int t = colt / split_cols; base += (size_t)t * split_stride; colt -= t * split_cols; if (t == 0) sc = scale0; }
        const int col0 = colt + wc * 32 + 8 * fq, bcol0 = u.pn * BM + wc * 32 + 8 * fq;
        f32x4 bv[2][2];
#pragma unroll
        for (int bj = 0; bj < 2; ++bj)
#pragma unroll
            for (int n = 0; n < 2; ++n) bv[bj][n] = bias ? *(const f32x4*)(bias + bcol0 + bj * HALF + 4 * n) : (f32x4){0.f, 0.f, 0.f, 0.f};
#pragma unroll
        for (int ai = 0; ai < 2; ++ai)
#pragma unroll
            for (int m = 0; m < 4; ++m) { bf16_t* rowp = base + (size_t)(row0 + ai * HALF + m * 16) * ldc + col0;
#pragma unroll
                for (int bj = 0; bj < 2; ++bj) { f32x4 v0 = acc[ai][bj][m][0] + bv[bj][0], v1 = acc[ai][bj][m][1] + bv[bj][1];
                    if (ACT == 1) { f32x2 a = gelu_pk((f32x2){v0[0], v0[1]}), b = gelu_pk((f32x2){v0[2], v0[3]}), c = gelu_pk((f32x2){v1[0], v1[1]}), d = gelu_pk((f32x2){v1[2], v1[3]});
                        v0 = (f32x4){a.x, a.y, b.x, b.y}; v1 = (f32x4){c.x, c.y, d.x, d.y}; }
                    v0 = v0 * sc; v1 = v1 * sc; u32x4 w; w.x = cvt_pk_bf16(v0[0], v0[1]); w.y = cvt_pk_bf16(v0[2], v0[3]); w.z = cvt_pk_bf16(v1[0], v1[1]); w.w = cvt_pk_bf16(v1[2], v1[3]);
                    *(u32x4*)(rowp + bj * HALF) = w; } }
    }
};

__device__ __forceinline__ float fast_exp2(float x) { return __builtin_amdgcn_exp2f(x); }
__device__ __forceinline__ float fast_rcp(float x) { return __builtin_amdgcn_rcpf(x); }
__device__ __forceinline__ float gelu_tanh(float x) {
    const float u = x * (1.0f + 0.044715f * x * x);
    const float e = fast_exp2(u * (-2.0f * 0.7978845608028654f * 1.4426950408889634f));
    return x * fast_rcp(1.0f + e);
}
__device__ __forceinline__ float sigmoid_f(float x) { return fast_rcp(1.0f + fast_exp2(x * -1.4426950408889634f)); }

struct EpiIn {
    static constexpr bool PERM = true, AFTER_DRAIN = false;
    bf16_t *Q, *Kb, *Vb, *GU, *GV; float qscale;
    __device__ __forceinline__ void operator()(const f32x4 (&acc)[2][2][4][2], const Unit& u, int wr, int wc, int fr, int fq) const {
        const int row0 = u.pm * BM + wr * 64 + fr; const int pn = u.pn; const int cw = wc * 32 + 8 * fq;
#pragma unroll
        for (int ai = 0; ai < 2; ++ai)
#pragma unroll
            for (int m = 0; m < 4; ++m) { const size_t row = (size_t)(row0 + ai * HALF + m * 16);
#pragma unroll
                for (int bj = 0; bj < 2; ++bj) { f32x4 v0 = acc[ai][bj][m][0], v1 = acc[ai][bj][m][1]; bf16_t* dst;
                    if (pn < 2) { v0 = v0 * qscale; v1 = v1 * qscale; dst = Q + row * 512 + pn * 256 + bj * HALF + cw; }
                    else if (pn == 2) { dst = (bj == 0 ? Kb : Vb) + row * 128 + cw; }
                    else { v0 = (f32x4){gelu_tanh(v0[0]), gelu_tanh(v0[1]), gelu_tanh(v0[2]), gelu_tanh(v0[3])}; v1 = (f32x4){gelu_tanh(v1[0]), gelu_tanh(v1[1]), gelu_tanh(v1[2]), gelu_tanh(v1[3])};
                        dst = (pn < 5 ? GU + row * 512 + (pn - 3) * 256 : GV + row * 512 + (pn - 5) * 256) + bj * HALF + cw; }
                    u32x4 w; w.x = cvt_pk_bf16(v0[0], v0[1]); w.y = cvt_pk_bf16(v0[2], v0[3]); w.z = cvt_pk_bf16(v1[0], v1[1]); w.w = cvt_pk_bf16(v1[2], v1[3]);
                    *(u32x4*)dst = w; } }
    }
};
struct EpiPlain {
    static constexpr bool PERM = true, AFTER_DRAIN = false;
    bf16_t* O; int ldc;
    __device__ __forceinline__ void operator()(const f32x4 (&acc)[2][2][4][2], const Unit& u, int wr, int wc, int fr, int fq) const {
        const int row0 = u.pm * BM + wr * 64 + fr; const int col0 = u.pn * BM + wc * 32 + 8 * fq;
#pragma unroll
        for (int ai = 0; ai < 2; ++ai)
#pragma unroll
            for (int m = 0; m < 4; ++m) { bf16_t* dst = O + (size_t)(row0 + ai * HALF + m * 16) * ldc + col0;
#pragma unroll
                for (int bj = 0; bj < 2; ++bj) { const f32x4 v0 = acc[ai][bj][m][0], v1 = acc[ai][bj][m][1];
                    u32x4 w; w.x = cvt_pk_bf16(v0[0], v0[1]); w.y = cvt_pk_bf16(v0[2], v0[3]); w.z = cvt_pk_bf16(v1[0], v1[1]); w.w = cvt_pk_bf16(v1[2], v1[3]);
                    *(u32x4*)(dst + bj * HALF) = w; } }
    }
};
struct EpiSwiGLU {
    static constexpr bool PERM = true, AFTER_DRAIN = false;
    bf16_t* O; int ldc;
    __device__ __forceinline__ void operator()(const f32x4 (&acc)[2][2][4][2], const Unit& u, int wr, int wc, int fr, int fq) const {
        const int row0 = u.pm * BM + wr * 64 + fr; const int col0 = u.pn * HALF + wc * 32 + 8 * fq;
#pragma unroll
        for (int ai = 0; ai < 2; ++ai)
#pragma unroll
            for (int m = 0; m < 4; ++m) { bf16_t* dst = O + (size_t)(row0 + ai * HALF + m * 16) * ldc + col0;
                f32x4 o[2];
#pragma unroll
                for (int n = 0; n < 2; ++n) { const f32x4 g = acc[ai][0][m][n], up = acc[ai][1][m][n];
#pragma unroll
                    for (int j = 0; j < 4; ++j) o[n][j] = g[j] * sigmoid_f(g[j]) * up[j]; }
                u32x4 w; w.x = cvt_pk_bf16(o[0][0], o[0][1]); w.y = cvt_pk_bf16(o[0][2], o[0][3]); w.z = cvt_pk_bf16(o[1][0], o[1][1]); w.w = cvt_pk_bf16(o[1][2], o[1][3]);
                *(u32x4*)dst = w; }
    }
};

struct RmsStats {
    unsigned* xbuf;
    unsigned* cnt;
    float eps;
    __device__ __forceinline__ void run(const f32x4 (&v)[2][2][4][2], const Unit& u, int wr, int wc, int fr, int fq, PG8_LAS unsigned char* lds, int wid, int lane) const {
        run_a(v, u, wr, wc, fr, fq, lds, wid, lane); run_b(u, lds, wid, lane); }
    __device__ __forceinline__ void run_a(const f32x4 (&v)[2][2][4][2], const Unit& u, int wr, int wc, int fr, int fq, PG8_LAS unsigned char* lds, int wid, int lane) const {
        PG8_LAS float* P = (PG8_LAS float*)lds;
#pragma unroll
        for (int ai = 0; ai < 2; ++ai)
#pragma unroll
            for (int m = 0; m < 4; ++m) {
                float q = 0.f;
#pragma unroll
                for (int bj = 0; bj < 2; ++bj)
#pragma unroll
                    for (int n = 0; n < 2; ++n) { const f32x4 x = v[ai][bj][m][n]; q += (x[0] * x[0] + x[1] * x[1]) + (x[2] * x[2] + x[3] * x[3]); }
                q += __shfl_xor(q, 16); q += __shfl_xor(q, 32);
                if (fq == 0) P[(ai * HALF + wr * 64 + m * 16 + fr) * 4 + wc] = q;
            }
        asm volatile("s_waitcnt lgkmcnt(0)" ::: "memory"); __builtin_amdgcn_s_barrier(); asm volatile("" ::: "memory");
        const int row = wid * 32 + (lane & 31);
        if (lane < 32) {
            const float t = (P[row * 4 + 0] + P[row * 4 + 1]) + (P[row * 4 + 2] + P[row * 4 + 3]);
            unsigned* slot = xbuf + ((size_t)(u.pm * BM + row) * 4 + u.pn);
            __hip_atomic_store(slot, __float_as_uint(t) | 1u, __ATOMIC_RELAXED, __HIP_MEMORY_SCOPE_AGENT);
        }
    }
    __device__ __forceinline__ void run_b(const Unit& u, PG8_LAS unsigned char* lds, int wid, int lane) const {
        PG8_LAS float* S = (PG8_LAS float*)(lds + 4096);
        const int row = wid * 32 + (lane & 31);
        if (lane < 32) {
            const unsigned* slot = xbuf + (size_t)(u.pm * BM + row) * 4; unsigned a = 0u, b2 = 0u, c = 0u, d = 0u;
            for (unsigned it = 0; it < (1u << 20); ++it) {
                a = __hip_atomic_load(slot + 0, __ATOMIC_RELAXED, __HIP_MEMORY_SCOPE_AGENT); b2 = __hip_atomic_load(slot + 1, __ATOMIC_RELAXED, __HIP_MEMORY_SCOPE_AGENT);
                c = __hip_atomic_load(slot + 2, __ATOMIC_RELAXED, __HIP_MEMORY_SCOPE_AGENT); d = __hip_atomic_load(slot + 3, __ATOMIC_RELAXED, __HIP_MEMORY_SCOPE_AGENT);
                if (__all((a != 0u) & (b2 != 0u) & (c != 0u) & (d != 0u))) break;
                __builtin_amdgcn_s_sleep(1);
            }
            const float s = (__uint_as_float(a) + __uint_as_float(b2)) + (__uint_as_float(c) + __uint_as_float(d));
            S[row] = 1.0f / sqrtf(s * (1.0f / 1024.0f) + eps);
        }
        asm volatile("s_waitcnt vmcnt(0) lgkmcnt(0)" ::: "memory"); __builtin_amdgcn_s_barrier(); asm volatile("" ::: "memory");
    }
};
constexpr int TAB_OFF = 131072 + 1024;
#define EPI_GLDS(gptr, lds, wid, q) __builtin_amdgcn_global_load_lds((const unsigned*)(gptr), (PG8_LAS unsigned*)((lds) + (wid) * 16384 + (q) * 1024), 16, 0, 0)
#define EPI_LDSV(lds, wid, q, lane) (*(const PG8_LAS f32x4*)((lds) + (wid) * 16384 + (q) * 1024 + (lane) * 16))
struct EpiRmsResRms {
    static constexpr bool PERM = true, AFTER_DRAIN = true;
    const float* base; float* out; bf16_t* xn; int ldc; const float* gpost; RmsStats st1, st2;
#ifdef PROBE_XCHG
    RmsStats st3;
#endif
    __device__ __forceinline__ void fused(f32x4 (&acc)[2][2][4][2], const Unit& u, int wr, int wc, int fr, int fq, PG8_LAS unsigned char* lds, int wid, int lane) const {
        typedef unsigned u32x2v __attribute__((ext_vector_type(2)));
        PG8_LAS unsigned char* tab = lds + TAB_OFF;
        const PG8_LAS float* S = (const PG8_LAS float*)(tab + 4096);
        const int col0 = u.pn * BM + wc * 32 + 8 * fq;
        st1.run_a(acc, u, wr, wc, fr, fq, tab, wid, lane);
#pragma unroll
        for (int m = 0; m < 4; ++m) { const size_t off = (size_t)(u.pm * BM + wr * 64 + m * 16 + fr) * ldc + col0;
#pragma unroll
            for (int bj = 0; bj < 2; ++bj)
#pragma unroll
                for (int n = 0; n < 2; ++n) EPI_GLDS(base + off + bj * HALF + n * 4, lds, wid, m * 4 + bj * 2 + n); }
        f32x4 pre[3][2][2];
#pragma unroll
        for (int m = 0; m < 3; ++m) { const size_t off = (size_t)(u.pm * BM + HALF + wr * 64 + m * 16 + fr) * ldc + col0;
#pragma unroll
            for (int bj = 0; bj < 2; ++bj)
#pragma unroll
                for (int n = 0; n < 2; ++n) pre[m][bj][n] = *(const f32x4*)(base + off + bj * HALF + n * 4); }
        st1.run_b(u, tab, wid, lane);
        f32x4 gv[2][2];
#pragma unroll
        for (int bj = 0; bj < 2; ++bj)
#pragma unroll
            for (int n = 0; n < 2; ++n) gv[bj][n] = *(const f32x4*)(gpost + col0 + bj * HALF + n * 4);
#pragma unroll
        for (int ai = 0; ai < 2; ++ai)
#pragma unroll
            for (int m = 0; m < 4; ++m) { const int r = ai * HALF + wr * 64 + m * 16 + fr; const float sr = S[r]; const size_t off = (size_t)(u.pm * BM + r) * ldc + col0;
#pragma unroll
                for (int bj = 0; bj < 2; ++bj)
#pragma unroll
                    for (int n = 0; n < 2; ++n) { const f32x4 bs = (ai == 0) ? EPI_LDSV(lds, wid, m * 4 + bj * 2 + n, lane) : ((m < 3) ? pre[m < 3 ? m : 0][bj][n] : *(const f32x4*)(base + off + bj * HALF + n * 4));
                        acc[ai][bj][m][n] = bs + (acc[ai][bj][m][n] * sr) * gv[bj][n]; }
                asm volatile("" : "+v"(acc[ai][0][m][0]), "+v"(acc[ai][0][m][1]), "+v"(acc[ai][1][m][0]), "+v"(acc[ai][1][m][1]));
                if (m & 1) asm volatile("" ::: "memory"); }
        st2.run(acc, u, wr, wc, fr, fq, tab, wid, lane);
#ifdef PROBE_XCHG
        st3.run(acc, u, wr, wc, fr, fq, tab, wid, lane);
#endif
#pragma unroll
        for (int ai = 0; ai < 2; ++ai)
#pragma unroll
            for (int m = 0; m < 4; ++m) { const int r = ai * HALF + wr * 64 + m * 16 + fr; const float sr = S[r]; const size_t off = (size_t)(u.pm * BM + r) * ldc + col0;
#pragma unroll
                for (int bj = 0; bj < 2; ++bj) { const f32x4 x0 = acc[ai][bj][m][0], x1 = acc[ai][bj][m][1];
                    *(f32x4*)(out + off + bj * HALF) = x0; *(f32x4*)(out + off + bj * HALF + 4) = x1;
                    const f32x4 o0 = x0 * sr, o1 = x1 * sr; u32x4 w; w.x = cvt_pk_bf16(o0[0], o0[1]); w.y = cvt_pk_bf16(o0[2], o0[3]); w.z = cvt_pk_bf16(o1[0], o1[1]); w.w = cvt_pk_bf16(o1[2], o1[3]);
                    *(u32x4*)(xn + off + bj * HALF) = w; }
                asm volatile("" ::: "memory"); }
    }
};
template <bool LAST> struct EpiPle {
    static constexpr bool PERM = true, AFTER_DRAIN = true;
    const float* base; float* out; bf16_t* xn; const bf16_t* T; int ldc; RmsStats st;
    __device__ __forceinline__ void fused(f32x4 (&acc)[2][2][4][2], const Unit& u, int wr, int wc, int fr, int fq, PG8_LAS unsigned char* lds, int wid, int lane) const {
        typedef unsigned u32x2v __attribute__((ext_vector_type(2)));
        PG8_LAS unsigned char* tab = lds + TAB_OFF;
        const PG8_LAS float* S = (const PG8_LAS float*)(tab + 4096);
        const int col0 = u.pn * BM + wc * 32 + 8 * fq;
#pragma unroll
        for (int m = 0; m < 4; ++m) { const size_t off = (size_t)(u.pm * BM + wr * 64 + m * 16 + fr) * ldc + col0;
#pragma unroll
            for (int bj = 0; bj < 2; ++bj)
#pragma unroll
                for (int n = 0; n < 2; ++n) EPI_GLDS(base + off + bj * HALF + n * 4, lds, wid, m * 4 + bj * 2 + n); }
        u32x4 tpre[4][2];
#pragma unroll
        for (int m = 0; m < 4; ++m) { const size_t off = (size_t)(u.pm * BM + wr * 64 + m * 16 + fr) * ldc + col0;
#pragma unroll
            for (int bj = 0; bj < 2; ++bj) tpre[m][bj] = *(const u32x4*)(T + off + bj * HALF); }
        asm volatile("s_waitcnt vmcnt(0)" ::: "memory"); __builtin_amdgcn_s_barrier(); asm volatile("" ::: "memory");
#pragma unroll
        for (int ai = 0; ai < 2; ++ai)
#pragma unroll
            for (int m = 0; m < 4; ++m) { const int r = ai * HALF + wr * 64 + m * 16 + fr; const size_t off = (size_t)(u.pm * BM + r) * ldc + col0;
#pragma unroll
                for (int bj = 0; bj < 2; ++bj)
#pragma unroll
                    for (int n = 0; n < 2; ++n) { const f32x4 bs = (ai == 0) ? EPI_LDSV(lds, wid, m * 4 + bj * 2 + n, lane) : *(const f32x4*)(base + off + bj * HALF + n * 4); const u32x4 tq = (ai == 0) ? tpre[m][bj] : *(const u32x4*)(T + off + bj * HALF); u32x2v tw; tw.x = n ? tq.z : tq.x; tw.y = n ? tq.w : tq.y;
                        f32x4 tv; tv[0] = __uint_as_float(tw.x << 16); tv[1] = __uint_as_float(tw.x & 0xffff0000u); tv[2] = __uint_as_float(tw.y << 16); tv[3] = __uint_as_float(tw.y & 0xffff0000u);
                        const f32x4 a = acc[ai][bj][m][n]; f32x4 o;
#pragma unroll
                        for (int j = 0; j < 4; ++j) o[j] = bs[j] + tv[j] * sigmoid_f(a[j]);
                        acc[ai][bj][m][n] = o;
                        if (LAST) *(f32x4*)(out + off + bj * HALF + n * 4) = o; }
                asm volatile("" : "+v"(acc[ai][0][m][0]), "+v"(acc[ai][0][m][1]), "+v"(acc[ai][1][m][0]), "+v"(acc[ai][1][m][1]));
                if (m & 1) asm volatile("" ::: "memory"); }
        if (!LAST) {
            st.run(acc, u, wr, wc, fr, fq, tab, wid, lane);
#pragma unroll
            for (int ai = 0; ai < 2; ++ai)
#pragma unroll
                for (int m = 0; m < 4; ++m) { const int r = ai * HALF + wr * 64 + m * 16 + fr; const float sr = S[r]; const size_t off = (size_t)(u.pm * BM + r) * ldc + col0;
#pragma unroll
                    for (int bj = 0; bj < 2; ++bj) { const f32x4 x0 = acc[ai][bj][m][0], x1 = acc[ai][bj][m][1];
                        *(f32x4*)(out + off + bj * HALF) = x0; *(f32x4*)(out + off + bj * HALF + 4) = x1;
                        const f32x4 o0 = x0 * sr, o1 = x1 * sr; u32x4 w; w.x = cvt_pk_bf16(o0[0], o0[1]); w.y = cvt_pk_bf16(o0[2], o0[3]); w.z = cvt_pk_bf16(o1[0], o1[1]); w.w = cvt_pk_bf16(o1[2], o1[3]);
                        *(u32x4*)(xn + off + bj * HALF) = w; }
                    asm volatile("" ::: "memory"); }
        }
    }
};

template <class Epi, class Sched, bool ALIGN_EPI = false, bool SP2 = false>
__device__ __forceinline__ void gemm_phase(PG8_LAS unsigned char* lds, const Gemm g, const Sched& S, const Epi& E) {
    int tid_l = threadIdx.x; asm volatile("" : "+v"(tid_l));
    const int tid = tid_l, wid = __builtin_amdgcn_readfirstlane(tid >> 6), lane = tid & 63, wr = wid >> 2, wc = wid & 3, fr = lane & 15, fq = lane >> 4;
    int K_l = g.K; asm volatile("" : "+s"(K_l));
    const int K = K_l, nt = K / BK;
    unsigned voffA[2], voffB[2];
#pragma unroll
    for (int i = 0; i < 2; ++i) { int R, C; stage_rc(tid * 16 + i * 8192, R, C); const int Rb = Epi::PERM ? ((R & ~31) + perm32(R & 31)) : R;
        voffA[i] = (unsigned)(R * K + C) * 2u; voffB[i] = (unsigned)(Rb * K + C) * 2u; }
    const size_t kstep = (size_t)(BK * 2);
    const size_t hstep = (size_t)HALF * K * 2;
    const size_t tstep = 2 * hstep;
    const unsigned ldsw = (unsigned)wid * 1024u;
    const int aoff = lds_byte(wr * 64 + fr, fq * 8), boff = lds_byte(wc * 32 + fr, fq * 8);
#define PG8_SA(b, h) (((b) * 2 + (h)) * HTB)
#define PG8_SB(b, h) ((4 + (b) * 2 + (h)) * HTB)
#define PG8_STAGE(bufoff, gbase, voff) do { _Pragma("unroll") for (int _i = 0; _i < 2; ++_i) \
        __builtin_amdgcn_global_load_lds((const unsigned*)((const char*)(gbase) + (voff)[_i]), (PG8_LAS unsigned*)(lds + (bufoff) + ldsw + _i * 8192), 16, 0, 0); } while (0)
#define PG8_LDA(dst, b, h) do { _Pragma("unroll") for (int m = 0; m < 4; ++m) _Pragma("unroll") for (int k = 0; k < 2; ++k) dst[m][k] = *(const PG8_LAS bf16x8*)(lds + PG8_SA(b, h) + aoff + m * 2048 + k * 1024); } while (0)
#define PG8_LDB(dst, b, h) do { _Pragma("unroll") for (int n = 0; n < 2; ++n) _Pragma("unroll") for (int k = 0; k < 2; ++k) dst[n][k] = *(const PG8_LAS bf16x8*)(lds + PG8_SB(b, h) + boff + n * 2048 + k * 1024); } while (0)
#define PG8_MMA(ai, bj, At, Bt) do { __builtin_amdgcn_s_setprio(1); _Pragma("unroll") for (int m = 0; m < 4; ++m) _Pragma("unroll") for (int n = 0; n < 2; ++n) _Pragma("unroll") for (int k = 0; k < 2; ++k) \
        acc[ai][bj][m][n] = __builtin_amdgcn_mfma_f32_16x16x32_bf16(Bt[n][k], At[m][k], acc[ai][bj][m][n], 0, 0, 0); __builtin_amdgcn_s_setprio(0); } while (0)
#define PG8_WAIT_V(n) asm volatile("s_waitcnt vmcnt(" #n ")" ::: "memory")
#define PG8_WAIT_L(n) asm volatile("s_waitcnt lgkmcnt(" #n ")" ::: "memory")
#define PG8_BAR __builtin_amdgcn_s_barrier()
#define PG8_SCHED __builtin_amdgcn_sched_barrier(0)
    Unit cur, nxt; int ui = 0;
    if (!S.next(0, cur)) return;
    f32x4 acc[2][2][4][2];
#pragma unroll
    for (int a = 0; a < 2; ++a)
#pragma unroll
        for (int b = 0; b < 2; ++b)
#pragma unroll
            for (int m = 0; m < 4; ++m)
#pragma unroll
                for (int n = 0; n < 2; ++n) acc[a][b][m][n] = (f32x4){0.f, 0.f, 0.f, 0.f};
    bf16x8 At[4][2], B0[2][2], B1[2][2];
    const char* cA = (const char*)g.A + (size_t)cur.pm * tstep; const char* cB = (const char*)g.Bt + (size_t)cur.pn * tstep;
    S.a_ready(cur);
    if constexpr (SP2) {
        PG8_STAGE(PG8_SB(0, 0), cB, voffB); PG8_STAGE(PG8_SB(0, 1), cB + hstep, voffB); PG8_STAGE(PG8_SA(0, 0), cA, voffA); PG8_STAGE(PG8_SA(0, 1), cA + hstep, voffA);
        if (wr == 1) PG8_BAR;
        PG8_WAIT_V(2); PG8_BAR;
        PG8_STAGE(PG8_SB(1, 0), cB + kstep, voffB); PG8_STAGE(PG8_SA(1, 0), cA + kstep, voffA); PG8_STAGE(PG8_SB(1, 1), cB + hstep + kstep, voffB);
        PG8_WAIT_V(6); PG8_BAR;
    } else {
        PG8_STAGE(PG8_SB(0, 0), cB, voffB); PG8_STAGE(PG8_SA(0, 0), cA, voffA); PG8_STAGE(PG8_SB(0, 1), cB + hstep, voffB); PG8_STAGE(PG8_SA(0, 1), cA + hstep, voffA);
        if (wr == 1) PG8_BAR;
        PG8_WAIT_V(4); PG8_BAR;
        PG8_STAGE(PG8_SB(1, 0), cB + kstep, voffB); PG8_STAGE(PG8_SA(1, 0), cA + kstep, voffA); PG8_STAGE(PG8_SB(1, 1), cB + hstep + kstep, voffB);
        PG8_WAIT_V(6); PG8_BAR;
    }
    for (;;) {
        const bool has_next = S.next(ui + 1, nxt);
        const char* nA = has_next ? (const char*)g.A + (size_t)nxt.pm * tstep : cA; const char* nB = has_next ? (const char*)g.Bt + (size_t)nxt.pn * tstep : cB;
        for (int t = 0; t < nt; t += 2) {
            const bool last = (t == nt - 2);
            const char* a1 = cA + (size_t)(t + 1) * kstep;
            const char* a2 = last ? nA : cA + (size_t)(t + 2) * kstep; const char* b2 = last ? nB : cB + (size_t)(t + 2) * kstep;
            const char* a3 = a2 + kstep; const char* b3 = b2 + kstep;
            if (last && has_next) S.a_ready(nxt);
            if constexpr (SP2) {
            PG8_LDB(B0, 0, 0); PG8_LDB(B1, 0, 1); PG8_SCHED; PG8_LDA(At, 0, 0); PG8_STAGE(PG8_SA(1, 1), a1 + hstep, voffA);
            PG8_WAIT_V(8); PG8_WAIT_L(0); PG8_BAR; PG8_MMA(0, 0, At, B0); PG8_MMA(0, 1, At, B1); PG8_BAR; PG8_SCHED;
            PG8_LDA(At, 0, 1); PG8_STAGE(PG8_SB(0, 0), b2, voffB); PG8_STAGE(PG8_SB(0, 1), b2 + hstep, voffB); PG8_STAGE(PG8_SA(0, 0), a2, voffA);
            PG8_WAIT_V(8); PG8_WAIT_L(0); PG8_BAR; PG8_MMA(1, 0, At, B0); PG8_MMA(1, 1, At, B1); PG8_BAR; PG8_SCHED;
            PG8_LDB(B0, 1, 0); PG8_LDB(B1, 1, 1); PG8_SCHED; PG8_LDA(At, 1, 0); PG8_STAGE(PG8_SA(0, 1), a2 + hstep, voffA);
            PG8_WAIT_V(8); PG8_WAIT_L(0); PG8_BAR; PG8_MMA(0, 0, At, B0); PG8_MMA(0, 1, At, B1); PG8_BAR; PG8_SCHED;
            PG8_LDA(At, 1, 1); PG8_STAGE(PG8_SB(1, 0), b3, voffB); PG8_STAGE(PG8_SB(1, 1), b3 + hstep, voffB); PG8_STAGE(PG8_SA(1, 0), a3, voffA);
            PG8_WAIT_V(8); PG8_WAIT_L(0); PG8_BAR; PG8_MMA(1, 0, At, B0); PG8_MMA(1, 1, At, B1); PG8_BAR; PG8_SCHED;
            } else {
            PG8_LDB(B0, 0, 0); PG8_SCHED; PG8_LDA(At, 0, 0); PG8_STAGE(PG8_SA(1, 1), a1 + hstep, voffA);
            PG8_WAIT_L(8); PG8_BAR; PG8_WAIT_L(0); PG8_MMA(0, 0, At, B0); PG8_BAR; PG8_SCHED;
            PG8_LDB(B1, 0, 1); PG8_STAGE(PG8_SB(0, 0), b2, voffB);
            PG8_BAR; PG8_WAIT_L(0); PG8_MMA(0, 1, At, B1); PG8_BAR;
            PG8_LDA(At, 0, 1); PG8_STAGE(PG8_SA(0, 0), a2, voffA);
            PG8_BAR; PG8_WAIT_L(0); PG8_MMA(1, 0, At, B0); PG8_BAR; PG8_SCHED;
            PG8_STAGE(PG8_SB(0, 1), b2 + hstep, voffB);
            PG8_WAIT_V(6); PG8_BAR; PG8_MMA(1, 1, At, B1); PG8_BAR;
            PG8_LDB(B0, 1, 0); PG8_SCHED; PG8_LDA(At, 1, 0); PG8_STAGE(PG8_SA(0, 1), a2 + hstep, voffA);
            PG8_WAIT_L(8); PG8_BAR; PG8_WAIT_L(0); PG8_MMA(0, 0, At, B0); PG8_BAR; PG8_SCHED;
            PG8_LDB(B1, 1, 1); PG8_STAGE(PG8_SB(1, 0), b3, voffB);
            PG8_BAR; PG8_WAIT_L(0); PG8_MMA(0, 1, At, B1); PG8_BAR;
            PG8_LDA(At, 1, 1); PG8_STAGE(PG8_SA(1, 0), a3, voffA);
            PG8_BAR; PG8_WAIT_L(0); PG8_MMA(1, 0, At, B0); PG8_BAR; PG8_SCHED;
            PG8_STAGE(PG8_SB(1, 1), b3 + hstep, voffB);
            PG8_WAIT_V(6); PG8_BAR; PG8_MMA(1, 1, At, B1); PG8_BAR;
            }
        }
        if constexpr (ALIGN_EPI) { if (wr == 0) PG8_BAR; }
        if constexpr (!Epi::AFTER_DRAIN) { E(acc, cur, wr, wc, fr, fq); S.done(cur); }
        if (!has_next) break;
#pragma unroll
        for (int a = 0; a < 2; ++a)
#pragma unroll
            for (int b = 0; b < 2; ++b)
#pragma unroll
                for (int m = 0; m < 4; ++m)
#pragma unroll
                    for (int n = 0; n < 2; ++n) acc[a][b][m][n] = (f32x4){0.f, 0.f, 0.f, 0.f};
        cur = nxt; cA = nA; cB = nB; ++ui;
        if constexpr (ALIGN_EPI) { if (wr == 1) PG8_BAR; }
    }
    PG8_WAIT_V(0);
    if constexpr (!ALIGN_EPI) { if (wr == 0) PG8_BAR; }
    PG8_BAR;
    if constexpr (Epi::AFTER_DRAIN) { E.fused(acc, cur, wr, wc, fr, fq, lds, wid, lane); S.done(cur); }
#undef PG8_SA
#undef PG8_SB
#undef PG8_STAGE
#undef PG8_LDA
#undef PG8_LDB
#undef PG8_MMA
#undef PG8_WAIT_V
#undef PG8_WAIT_L
#undef PG8_BAR
#undef PG8_SCHED
}
}

#ifndef PHASES
#define PHASES 63
#endif
#ifndef REP_ATTN
#define REP_ATTN 1
#endif
#ifndef REP_GATE
#define REP_GATE 1
#endif
#ifndef REP_PRO
#define REP_PRO 1
#endif
#ifndef REP_P1
#define REP_P1 1
#endif
#ifndef REP_P4
#define REP_P4 1
#endif
#ifndef EXTRA_SYNC
#define EXTRA_SYNC 0
#endif
#ifndef PG8_SP2
#define PG8_SP2 true
#endif
#ifndef PG8_ALIGN
#define PG8_ALIGN true
#endif

constexpr int NWAVES = 8;
constexpr int BATCH = 2, SEQ = 8192, DM = 1024, DEPTH = 4;
constexpr int M = BATCH * SEQ;
constexpr int ATTN_W = 512, KV_W = 128, GM_W = 512, D_IN = 1792, D_FF = 2816, PLE = 256;
constexpr float NORM_EPS = 1e-6f;
constexpr float LOG2E = 1.4426950408889634f;

constexpr size_t MiB = 1u << 20;
constexpr size_t WS_CTL = 0, CTL_ZERO_BYTES = 1 * MiB;
constexpr size_t WS_X = 1 * MiB;
constexpr size_t XBANK_BYTES = 256 * 1024;
constexpr size_t WS_WIN = 8 * MiB;
constexpr size_t WS_WOUT = WS_WIN + (size_t)DEPTH * D_IN * DM * 2;
constexpr size_t WS_WGU = WS_WOUT + (size_t)DEPTH * DM * DM * 2;
constexpr size_t WS_WD = WS_WGU + (size_t)DEPTH * 2 * D_FF * DM * 2;
constexpr size_t WS_WP = WS_WD + (size_t)DEPTH * DM * D_FF * 2;
constexpr size_t WS_WPG = WS_WP + (size_t)DEPTH * DM * PLE * 2;
constexpr size_t WS_WTRIL = WS_WPG + (size_t)DEPTH * DM * DM * 2;
constexpr size_t WS_PB = WS_WTRIL + (size_t)DEPTH * 8 * 128 * 128 * 2;
constexpr size_t WS_XNA = WS_PB + (size_t)DEPTH * M * PLE * 2;
constexpr size_t WS_XNB = WS_XNA + (size_t)M * DM * 2;
constexpr size_t WS_OVL = WS_XNB + (size_t)M * DM * 2;
constexpr size_t WS_Q = WS_OVL;
constexpr size_t WS_K = WS_Q + (size_t)M * 512 * 2;
constexpr size_t WS_V = WS_K + (size_t)M * 128 * 2;
constexpr size_t WS_GU = WS_V + (size_t)M * 128 * 2;
constexpr size_t WS_GV = WS_GU + (size_t)M * 512 * 2;
constexpr size_t WS_HEADS = WS_GV + (size_t)M * 512 * 2;
constexpr size_t WS_HID = WS_OVL;
constexpr size_t WS_T = WS_OVL + (size_t)M * D_FF * 2;
constexpr size_t WS_END = WS_T + (size_t)M * DM * 2;
static_assert(WS_HEADS + (size_t)M * DM * 2 <= WS_END, "overlay");
static_assert(WS_X + 28 * XBANK_BYTES <= WS_WIN, "slots");
constexpr int CW_SEAM = 16384, SEAM_BANK = 64 * 64;
static_assert((CW_SEAM + 28 * SEAM_BANK) * 4 <= (int)CTL_ZERO_BYTES, "ctl");

constexpr int RING_BYTES = 131072;
constexpr int LDS_BYTES = 147456;

#define GAS __attribute__((address_space(1)))
#define LAS __attribute__((address_space(3)))
typedef unsigned short bf16;
typedef unsigned v4u __attribute__((ext_vector_type(4)));
typedef unsigned v2u __attribute__((ext_vector_type(2)));
typedef float f32x4 __attribute__((ext_vector_type(4)));
typedef short bf16x8 __attribute__((ext_vector_type(8)));
#define LDS_WAIT() asm volatile("s_waitcnt lgkmcnt(0)" ::: "memory")
__device__ __forceinline__ unsigned f2bf(float f) { unsigned u = __builtin_bit_cast(unsigned, f); return (u + 0x7fffu + ((u >> 16) & 1u)) >> 16; }
__device__ __forceinline__ unsigned pk2(float lo, float hi) { return pg8::cvt_pk_bf16(lo, hi); }
__device__ __forceinline__ float bflo(unsigned w) { return __uint_as_float(w << 16); }
__device__ __forceinline__ float bfhi(unsigned w) { return __uint_as_float(w & 0xffff0000u); }
__device__ __forceinline__ float wave_sum(float v) {
#pragma unroll
    for (int o = 1; o < 64; o <<= 1) v += __shfl_xor(v, o);
    return v;
}

struct Args {
    const float* in[21];
    float* out; unsigned char* ws;
};

__device__ __forceinline__ void p0_transpose_item(const float* W, int K, int N, bf16* WT, int mode, const float* g0, const float* g1, int gsplit, int item, int lane) {
    const int nblk = N / 32, kb = item / nblk, nb = item % nblk, k0 = 64 * kb + 8 * (lane >> 3), n0 = 32 * nb + 4 * (lane & 7);
    f32x4 v[8];
#pragma unroll
    for (int i = 0; i < 8; ++i) v[i] = __builtin_nontemporal_load((const GAS f32x4*)(W + (size_t)(k0 + i) * N + n0));
    if (g0) { const float* gp = g0 + k0; if (k0 >= gsplit) gp = g1 + (k0 - gsplit);
        const f32x4 ga = *(const GAS f32x4*)gp, gb = *(const GAS f32x4*)(gp + 4);
        v[0] = v[0] * ga.x; v[1] = v[1] * ga.y; v[2] = v[2] * ga.z; v[3] = v[3] * ga.w; v[4] = v[4] * gb.x; v[5] = v[5] * gb.y; v[6] = v[6] * gb.z; v[7] = v[7] * gb.w; }
#pragma unroll
    for (int j = 0; j < 4; ++j) { const int ns = n0 + j; const int row = (mode == 0) ? ns : ((ns >> 7) * 256 + (mode == 2 ? 128 : 0) + (ns & 127));
        v4u o; o.x = pk2(v[0][j], v[1][j]); o.y = pk2(v[2][j], v[3][j]); o.z = pk2(v[4][j], v[5][j]); o.w = pk2(v[6][j], v[7][j]);
        __builtin_nontemporal_store(o, (GAS v4u*)(WT + (size_t)row * K + k0)); }
}
__device__ __forceinline__ void rms_row_to_bf16(const float* xrow, bf16* orow, int lane) {
    const GAS f32x4* xr = (const GAS f32x4*)xrow + 2 * lane;
    f32x4 v[4]; float s = 0.f;
#pragma unroll
    for (int j = 0; j < 2; ++j) { v[2 * j] = __builtin_nontemporal_load(xr + 128 * j); v[2 * j + 1] = __builtin_nontemporal_load(xr + 128 * j + 1); }
#pragma unroll
    for (int j = 0; j < 4; ++j) s += (v[j].x * v[j].x + v[j].y * v[j].y) + (v[j].z * v[j].z + v[j].w * v[j].w);
    const float rstd = 1.f / sqrtf(wave_sum(s) * (1.f / DM) + NORM_EPS);
    GAS v4u* o16 = (GAS v4u*)orow + lane;
#pragma unroll
    for (int j = 0; j < 2; ++j) { v4u o; o.x = pk2(v[2 * j].x * rstd, v[2 * j].y * rstd); o.y = pk2(v[2 * j].z * rstd, v[2 * j].w * rstd); o.z = pk2(v[2 * j + 1].x * rstd, v[2 * j + 1].y * rstd); o.w = pk2(v[2 * j + 1].z * rstd, v[2 * j + 1].w * rstd);
        o16[64 * j] = o; }
}
__device__ __forceinline__ void conv_weights(const Args& A, int l_lo, int l_hi, int gw, int NGW, int lane, int which) {
    unsigned char* ws = A.ws;
    const float* ln_mix_pre = A.in[2]; const float* w_in = A.in[3];
    const float* g_attn_out = A.in[9]; const float* g_gm_out = A.in[10]; const float* w_out = A.in[11];
    const float* ln_ffn_pre = A.in[13]; const float* w_gate = A.in[14]; const float* w_up = A.in[15]; const float* w_down = A.in[16];
    const float* w_ple = A.in[18]; const float* ln_ple_gate = A.in[19]; const float* w_pg = A.in[20];
    constexpr int I_IN = (DM / 64) * (D_IN / 32), I_OUT = (DM / 64) * (DM / 32), I_G = (DM / 64) * (D_FF / 32), I_D = (D_FF / 64) * (DM / 32), I_P = (PLE / 64) * (DM / 32), I_PG = I_OUT;
    constexpr int PER_LAYER = I_IN + I_OUT + 2 * I_G + I_D + I_P + I_PG;
    for (int it = l_lo * PER_LAYER + gw; it < l_hi * PER_LAYER; it += NGW) {
        const int L = it / PER_LAYER; int r = it % PER_LAYER;
        { const bool ffn = (r >= I_IN + I_OUT) && (r < I_IN + I_OUT + 2 * I_G + I_D); if ((which == 1 && ffn) || (which == 2 && !ffn)) continue; }
        const float* W; int K, N, mode = 0, gsplit = 1 << 30; bf16* WT; const float* g0; const float* g1;
        if (r < I_IN) { W = w_in + (size_t)L * DM * D_IN; K = DM; N = D_IN; WT = (bf16*)(ws + WS_WIN) + (size_t)L * D_IN * DM; g0 = ln_mix_pre + L * DM; g1 = g0; }
        else if ((r -= I_IN) < I_OUT) { W = w_out + (size_t)L * DM * DM; K = DM; N = DM; WT = (bf16*)(ws + WS_WOUT) + (size_t)L * DM * DM; g0 = g_attn_out + L * 512; g1 = g_gm_out + L * 512; gsplit = 512; }
        else if ((r -= I_OUT) < I_G) { W = w_gate + (size_t)L * DM * D_FF; K = DM; N = D_FF; WT = (bf16*)(ws + WS_WGU) + (size_t)L * 2 * D_FF * DM; mode = 1; g0 = ln_ffn_pre + L * DM; g1 = g0; }
        else if ((r -= I_G) < I_G) { W = w_up + (size_t)L * DM * D_FF; K = DM; N = D_FF; WT = (bf16*)(ws + WS_WGU) + (size_t)L * 2 * D_FF * DM; mode = 2; g0 = ln_ffn_pre + L * DM; g1 = g0; }
        else if ((r -= I_G) < I_D) { W = w_down + (size_t)L * D_FF * DM; K = D_FF; N = DM; WT = (bf16*)(ws + WS_WD) + (size_t)L * DM * D_FF; g0 = nullptr; g1 = nullptr; }
        else if ((r -= I_D) < I_P) { W = w_ple + (size_t)L * PLE * DM; K = PLE; N = DM; WT = (bf16*)(ws + WS_WP) + (size_t)L * DM * PLE; g0 = nullptr; g1 = nullptr; }
        else { r -= I_P; W = w_pg + (size_t)L * DM * DM; K = DM; N = DM; WT = (bf16*)(ws + WS_WPG) + (size_t)L * DM * DM; g0 = ln_ple_gate + L * DM; g1 = g0; }
        p0_transpose_item(W, K, N, WT, mode, g0, g1, gsplit, r, lane);
    }
}
__device__ __forceinline__ void conv_p(const Args& A, int L, int gt, int NT) {
    const float* p = A.in[1] + (size_t)L * M * PLE; bf16* pb = (bf16*)(A.ws + WS_PB) + (size_t)L * M * PLE;
    for (int i = gt; i < M * PLE / 8; i += NT) { const size_t e0 = (size_t)i * 8;
        const f32x4 a = __builtin_nontemporal_load((const GAS f32x4*)(p + e0)), b = __builtin_nontemporal_load((const GAS f32x4*)(p + e0 + 4));
        v4u o; o.x = pk2(a.x, a.y); o.y = pk2(a.z, a.w); o.z = pk2(b.x, b.y); o.w = pk2(b.z, b.w);
        __builtin_nontemporal_store(o, (GAS v4u*)(pb + e0)); }
}
__device__ __forceinline__ void p0_prologue(const Args& A, LAS unsigned char* lds, int vcu, int G, int wave, int lane) {
    (void)lds;
    const int gw = vcu * NWAVES + wave, NGW = G * NWAVES;
    unsigned char* ws = A.ws; const float* gm_ws = A.in[7];
    conv_weights(A, 0, 1, gw, NGW, lane, 0);
    conv_weights(A, 1, DEPTH, gw, NGW, lane, 2);
    { const int gt = gw * 64 + lane, NT = NGW * 64;
      for (int i = gt; i < DEPTH * 8 * 128 * 128 / 8; i += NT) { const int e0 = i * 8; const int t = (e0 >> 7) & 127, s0 = e0 & 127;
          const f32x4 a = *(const GAS f32x4*)(gm_ws + e0), b = *(const GAS f32x4*)(gm_ws + e0 + 4);
          v4u o; o.x = pk2(s0 + 0 <= t ? a.x : 0.f, s0 + 1 <= t ? a.y : 0.f); o.y = pk2(s0 + 2 <= t ? a.z : 0.f, s0 + 3 <= t ? a.w : 0.f);
          o.z = pk2(s0 + 4 <= t ? b.x : 0.f, s0 + 5 <= t ? b.y : 0.f); o.w = pk2(s0 + 6 <= t ? b.z : 0.f, s0 + 7 <= t ? b.w : 0.f);
          *(GAS v4u*)((bf16*)(ws + WS_WTRIL) + e0) = o; } }
    for (int m = gw; m < M; m += NGW) rms_row_to_bf16(A.in[0] + (size_t)m * DM, (bf16*)(ws + WS_XNA) + (size_t)m * DM, lane);
    { const int gt = gw * 64 + lane, NT = NGW * 64; for (int i = gt; i < (int)(20 * XBANK_BYTES / 16); i += NT) *(GAS v4u*)(ws + WS_X + (size_t)i * 16) = (v4u){0u, 0u, 0u, 0u}; }
}

constexpr int KS_STRIDE = 72, VT_STRIDE = 200;
constexpr int ALDS_KS = 0;
constexpr int ALDS_VT = 55296;
constexpr int ALDS_RED = 106496;
__device__ __forceinline__ void attn_unit(int b, int qb, const bf16* Qg, const bf16* Kg, const bf16* Vg, bf16* Hd, const float* sinks, LAS unsigned char* lds) {
    int tid_l = threadIdx.x; asm volatile("" : "+v"(tid_l));
    const int tid = tid_l, lane = tid & 63, fr = lane & 15, g = lane >> 4; const int wid = __builtin_amdgcn_readfirstlane(tid >> 6);
    const long rowb = (long)b * SEQ; const int t0 = qb * 64, j0 = t0 - 128;
    const int hq = wid, kvh = hq >> 2;
    const float slope2 = __builtin_amdgcn_exp2f(-(float)(hq + 1)) * LOG2E;
    const float sink2 = sinks[hq] * LOG2E;
    bf16x8 qf[4][2];
#pragma unroll
    for (int qt = 0; qt < 4; ++qt)
#pragma unroll
        for (int ds = 0; ds < 2; ++ds) qf[qt][ds] = *(const GAS bf16x8*)(Qg + (size_t)(rowb + t0 + 16 * qt + fr) * ATTN_W + hq * 64 + 32 * ds + 8 * g);
#ifndef REP_ASTAGE
#define REP_ASTAGE 1
#endif
#ifndef REP_ACOMP
#define REP_ACOMP 1
#endif
    for (int rs_ = 0; rs_ < REP_ASTAGE; ++rs_) { if (rs_) __syncthreads();
#pragma unroll
    for (int it = 0; it < 6; ++it) { const int idx = it * 512 + tid; const int key = idx >> 4, c = idx & 15; const int j = j0 + key;
        v4u v = (v4u){0u, 0u, 0u, 0u}; if (j >= 0) v = *(const GAS v4u*)(Kg + (size_t)(rowb + j) * KV_W + c * 8);
        const int kvh = c >> 3, d0 = (c & 7) * 8;
        *(LAS v4u*)(lds + ALDS_KS + ((kvh * 192 + key) * KS_STRIDE + d0) * 2) = v; }
#pragma unroll
    for (int it = 0; it < 3; ++it) { const int idx = it * 512 + tid; const int kp = idx % 96, c = idx / 96; const int j = j0 + 2 * kp;
        v4u va = (v4u){0u, 0u, 0u, 0u}, vb = (v4u){0u, 0u, 0u, 0u};
        if (j >= 0) { va = *(const GAS v4u*)(Vg + (size_t)(rowb + j) * KV_W + c * 8); vb = *(const GAS v4u*)(Vg + (size_t)(rowb + j + 1) * KV_W + c * 8); }
        const int kvh = c >> 3, d0 = (c & 7) * 8;
        LAS unsigned char* dst = lds + ALDS_VT + ((kvh * 64 + d0) * VT_STRIDE + 2 * kp) * 2;
#pragma unroll
        for (int w = 0; w < 4; ++w) { const unsigned a = va[w], bb = vb[w];
            *(LAS unsigned*)(dst + (2 * w) * VT_STRIDE * 2) = (a & 0xffffu) | (bb << 16);
            *(LAS unsigned*)(dst + (2 * w + 1) * VT_STRIDE * 2) = (a >> 16) | (bb & 0xffff0000u); } }
    }
    __syncthreads();
    LAS float* red = (LAS float*)(lds + ALDS_RED);
    const LAS unsigned char* ksb = lds + ALDS_KS + ((kvh * 192 + fr) * KS_STRIDE + 8 * g) * 2;
    const int frp = 8 * ((fr >> 2) & 1) + 4 * (fr >> 3) + (fr & 3);
    const LAS unsigned char* vtb = lds + ALDS_VT + ((kvh * 64 + frp) * VT_STRIDE + 4 * g) * 2;
    f32x4 o[4][4];
    const int l0 = fr - 4 * g; const float nslope2 = -slope2, nb = nslope2 * (float)l0; const int kinv = (-j0) >> 4;
#pragma unroll
    for (int p = 0; p < 2; ++p) {
        const int kt0 = 2 * p;
        f32x4 s[2][10];
#pragma unroll
        for (int kk = 0; kk < 10; ++kk) {
#pragma unroll
            for (int q = 0; q < 2; ++q) {
                if (kk < q || kk > q + 8) s[q][kk] = (f32x4){0.f, 0.f, 0.f, 0.f};
                else {
#pragma unroll
                    for (int r = 0; r < 4; ++r) s[q][kk][r] = __builtin_fmaf(nslope2, (float)(16 * (2 * p + q) + 128 - 16 * (kt0 + kk) - r), nb); } }
#pragma unroll
            for (int ds = 0; ds < 2; ++ds) { const bf16x8 kf = *(const LAS bf16x8*)(ksb + ((kt0 + kk) * 16 * KS_STRIDE + 32 * ds) * 2);
                if (kk <= 8) s[0][kk] = __builtin_amdgcn_mfma_f32_16x16x32_bf16(kf, qf[2 * p][ds], s[0][kk], 0, 0, 0);
                if (kk >= 1) s[1][kk] = __builtin_amdgcn_mfma_f32_16x16x32_bf16(kf, qf[2 * p + 1][ds], s[1][kk], 0, 0, 0); } }
        float inv[2];
#pragma unroll
        for (int q = 0; q < 2; ++q) {
            const int klo = q;
#pragma unroll
            for (int r = 0; r < 4; ++r) { const bool lo_ok = (l0 - r) < 0; s[q][klo][r] = lo_ok ? s[q][klo][r] : -1e30f; s[q][klo + 8][r] = lo_ok ? -1e30f : s[q][klo + 8][r]; }
            if (kinv > 0) {
#pragma unroll
                for (int kk = 0; kk < 10; ++kk) if (kk >= klo && kk <= klo + 8 && kt0 + kk < kinv) s[q][kk] = (f32x4){-1e30f, -1e30f, -1e30f, -1e30f};
            }
            float mx = sink2;
#pragma unroll
            for (int kk = 0; kk < 10; ++kk) if (kk >= klo && kk <= klo + 8) mx = fmaxf(fmaxf(mx, fmaxf(s[q][kk][0], s[q][kk][1])), fmaxf(s[q][kk][2], s[q][kk][3]));
            mx = fmaxf(mx, __shfl_xor(mx, 16)); mx = fmaxf(mx, __shfl_xor(mx, 32));
            float sum = 0.f;
#pragma unroll
            for (int kk = 0; kk < 10; ++kk) if (kk >= klo && kk <= klo + 8) {
#pragma unroll
                for (int r = 0; r < 4; ++r) { const float e = __builtin_amdgcn_exp2f(s[q][kk][r] - mx); s[q][kk][r] = e; sum += e; } }
            sum += __shfl_xor(sum, 16); sum += __shfl_xor(sum, 32);
            inv[q] = 1.0f / (sum + __builtin_amdgcn_exp2f(sink2 - mx));
#pragma unroll
            for (int dt = 0; dt < 4; ++dt) o[2 * p + q][dt] = (f32x4){0.f, 0.f, 0.f, 0.f};
        }
#pragma unroll
        for (int kp = 0; kp < 5; ++kp) {
            bf16x8 pb[2];
#pragma unroll
            for (int q = 0; q < 2; ++q) { v4u pw; pw.x = pk2(s[q][2 * kp][0], s[q][2 * kp][1]); pw.y = pk2(s[q][2 * kp][2], s[q][2 * kp][3]); pw.z = pk2(s[q][2 * kp + 1][0], s[q][2 * kp + 1][1]); pw.w = pk2(s[q][2 * kp + 1][2], s[q][2 * kp + 1][3]);
                pb[q] = __builtin_bit_cast(bf16x8, pw); }
#pragma unroll
            for (int dt = 0; dt < 4; ++dt) { const LAS unsigned char* vp = vtb + (dt * 16 * VT_STRIDE + 16 * (kt0 + 2 * kp)) * 2;
                const v2u lo = *(const LAS v2u*)vp, hi = *(const LAS v2u*)(vp + 32);
                const bf16x8 vf = __builtin_bit_cast(bf16x8, ((v4u){lo.x, lo.y, hi.x, hi.y}));
                o[2 * p][dt] = __builtin_amdgcn_mfma_f32_16x16x32_bf16(vf, pb[0], o[2 * p][dt], 0, 0, 0);
                o[2 * p + 1][dt] = __builtin_amdgcn_mfma_f32_16x16x32_bf16(vf, pb[1], o[2 * p + 1][dt], 0, 0, 0); } }
#pragma unroll
        for (int q = 0; q < 2; ++q) { const int qt = 2 * p + q; float ss = 0.f;
#pragma unroll
            for (int dt = 0; dt < 4; ++dt) { o[qt][dt] = o[qt][dt] * inv[q]; ss += (o[qt][dt][0] * o[qt][dt][0] + o[qt][dt][1] * o[qt][dt][1]) + (o[qt][dt][2] * o[qt][dt][2] + o[qt][dt][3] * o[qt][dt][3]); }
            ss += __shfl_xor(ss, 16); ss += __shfl_xor(ss, 32);
            if (g == 0) red[wid * 64 + 16 * qt + fr] = ss; }
    }
    __syncthreads();
#pragma unroll
    for (int qt = 0; qt < 4; ++qt) { float tot = 0.f;
#pragma unroll
        for (int w = 0; w < 8; ++w) tot += red[w * 64 + 16 * qt + fr];
        const float rstd = 1.0f / sqrtf(tot * (1.0f / ATTN_W) + NORM_EPS);
        bf16* dst = Hd + (size_t)(rowb + t0 + 16 * qt + fr) * DM + hq * 64 + 8 * (g & 1) + 16 * (g >> 1);
#pragma unroll
        for (int dp = 0; dp < 2; ++dp) { v2u a, b2;
            a.x = pk2(o[qt][2 * dp][0] * rstd, o[qt][2 * dp][1] * rstd); a.y = pk2(o[qt][2 * dp][2] * rstd, o[qt][2 * dp][3] * rstd);
            b2.x = pk2(o[qt][2 * dp + 1][0] * rstd, o[qt][2 * dp + 1][1] * rstd); b2.y = pk2(o[qt][2 * dp + 1][2] * rstd, o[qt][2 * dp + 1][3] * rstd);
            { auto r0 = __builtin_amdgcn_permlane32_swap(a.x, b2.x, false, false); a.x = r0[0]; b2.x = r0[1]; auto r1 = __builtin_amdgcn_permlane32_swap(a.y, b2.y, false, false); a.y = r1[0]; b2.y = r1[1]; }
            *(GAS v4u*)(dst + 32 * dp) = (v4u){a.x, a.y, b2.x, b2.y}; } }
    __syncthreads();
}

constexpr int GLDS_LN = 0;
constexpr int GLDS_P1 = 73728, GLDS_P2 = 75776, GLDS_RED = 77824;
__device__ __forceinline__ void gate_unit(int b, int c, int th, const bf16* GUg, const bf16* GVg, bf16* Hd, const bf16* Wt, const float* lng, const float* lnb, const float* bs, LAS unsigned char* lds) {
    int tid_l = threadIdx.x; asm volatile("" : "+v"(tid_l));
    const int tid = tid_l, lane = tid & 63, fr = lane & 15, g = lane >> 4; const int wid = __builtin_amdgcn_readfirstlane(tid >> 6);
    const long rowc = (long)b * SEQ + c * 128;
    LAS unsigned char* lnw = lds + GLDS_LN + wid * 9216;
    LAS float* p1 = (LAS float*)(lds + GLDS_P1); LAS float* p2 = (LAS float*)(lds + GLDS_P2); LAS float* red = (LAS float*)(lds + GLDS_RED);
    const bf16* Wh = Wt + (size_t)wid * 128 * 128;
    const int frp = 8 * ((fr >> 2) & 1) + 4 * (fr >> 3) + (fr & 3);
    f32x4 acc[4][4];
#pragma unroll
    for (int tt = 0; tt < 4; ++tt)
#pragma unroll
        for (int ct = 0; ct < 4; ++ct) acc[tt][ct] = (f32x4){0.f, 0.f, 0.f, 0.f};
    v4u xa[8];
    const bf16* src0 = GVg + (size_t)(rowc + lane) * GM_W + wid * 64;
#pragma unroll
    for (int i = 0; i < 8; ++i) xa[i] = *(const GAS v4u*)(src0 + 8 * i);
    for (int sh = 0; sh <= th; ++sh) {
        float sm = 0.f;
#define x xa
#pragma unroll
        for (int i = 0; i < 8; ++i) {
#pragma unroll
            for (int w = 0; w < 4; ++w) sm += bflo(x[i][w]) + bfhi(x[i][w]); }
        bf16x8 wfr[4][2];
#pragma unroll
        for (int tt = 0; tt < 4; ++tt)
#pragma unroll
            for (int ks = 0; ks < 2; ++ks) wfr[tt][ks] = *(const GAS bf16x8*)(Wh + (size_t)(64 * th + 16 * tt + fr) * 128 + 64 * sh + 32 * ks + 8 * g);
        p1[wid * 64 + lane] = sm;
        __syncthreads();
        float tot = 0.f;
#pragma unroll
        for (int w = 0; w < 8; ++w) tot += p1[w * 64 + lane];
        const float mean = tot * (1.0f / GM_W);
        float sq = 0.f;
#pragma unroll
        for (int i = 0; i < 8; ++i)
#pragma unroll
            for (int w = 0; w < 4; ++w) { const float a = bflo(x[i][w]) - mean, bb = bfhi(x[i][w]) - mean; sq += a * a + bb * bb; }
        p2[wid * 64 + lane] = sq;
        __syncthreads();
        float tq = 0.f;
#pragma unroll
        for (int w = 0; w < 8; ++w) tq += p2[w * 64 + lane];
        const float rstd = 1.0f / sqrtf(tq * (1.0f / GM_W) + NORM_EPS);
#pragma unroll
        for (int i = 0; i < 8; ++i)
#pragma unroll
            for (int w = 0; w < 4; ++w) { const int f = 8 * i + 2 * w;
                const float y0 = (bflo(x[i][w]) - mean) * rstd * lng[wid * 64 + f] + lnb[wid * 64 + f];
                const float y1 = (bfhi(x[i][w]) - mean) * rstd * lng[wid * 64 + f + 1] + lnb[wid * 64 + f + 1];
                const unsigned yw = pk2(y0, y1);
                *(LAS unsigned short*)(lnw + (f * 72 + lane) * 2) = (unsigned short)(yw & 0xffffu);
                *(LAS unsigned short*)(lnw + ((f + 1) * 72 + lane) * 2) = (unsigned short)(yw >> 16); }
        LDS_WAIT(); asm volatile("" ::: "memory");
        if (sh < th) {
#pragma unroll
            for (int i = 0; i < 8; ++i) xa[i] = *(const GAS v4u*)(src0 + (size_t)64 * GM_W + 8 * i); }
#pragma unroll
        for (int tt = 0; tt < 4; ++tt)
#pragma unroll
            for (int ks = 0; ks < 2; ++ks) {
                if (64 * sh + 32 * ks <= 64 * th + 16 * tt + 15) {
                    const bf16x8 wf = wfr[tt][ks];
#pragma unroll
                    for (int ct = 0; ct < 4; ++ct) { const bf16x8 af = *(const LAS bf16x8*)(lnw + ((16 * ct + frp) * 72 + 32 * ks + 8 * g) * 2);
                        acc[tt][ct] = __builtin_amdgcn_mfma_f32_16x16x32_bf16(af, wf, acc[tt][ct], 0, 0, 0); }
                }
            }
        LDS_WAIT(); asm volatile("" ::: "memory");
    }
#undef x
#pragma unroll
    for (int tt = 0; tt < 4; ++tt) { const int tl = 64 * th + 16 * tt + fr; const float bsv = bs[wid * 128 + tl]; float ss = 0.f;
        const bf16* gsrc = GUg + (size_t)(rowc + tl) * GM_W + wid * 64 + 8 * (g & 1) + 16 * (g >> 1);
        v2u gws[4];
#pragma unroll
        for (int cp = 0; cp < 2; ++cp) { const v4u q = *(const GAS v4u*)(gsrc + 32 * cp); v2u a = (v2u){q.x, q.y}, b2 = (v2u){q.z, q.w};
            auto r0 = __builtin_amdgcn_permlane32_swap(a.x, b2.x, false, false); a.x = r0[0]; b2.x = r0[1]; auto r1 = __builtin_amdgcn_permlane32_swap(a.y, b2.y, false, false); a.y = r1[0]; b2.y = r1[1];
            gws[2 * cp] = a; gws[2 * cp + 1] = b2; }
#pragma unroll
        for (int ct = 0; ct < 4; ++ct) { const v2u gw = gws[ct];
            f32x4 v = acc[tt][ct]; v[0] = bflo(gw.x) * (v[0] + bsv); v[1] = bfhi(gw.x) * (v[1] + bsv); v[2] = bflo(gw.y) * (v[2] + bsv); v[3] = bfhi(gw.y) * (v[3] + bsv);
            acc[tt][ct] = v; ss += (v[0] * v[0] + v[1] * v[1]) + (v[2] * v[2] + v[3] * v[3]); }
        ss += __shfl_xor(ss, 16); ss += __shfl_xor(ss, 32);
        if (g == 0) red[wid * 64 + 16 * tt + fr] = ss; }
    __syncthreads();
#pragma unroll
    for (int tt = 0; tt < 4; ++tt) { float tot = 0.f;
#pragma unroll
        for (int w = 0; w < 8; ++w) tot += red[w * 64 + 16 * tt + fr];
        const float rstd = 1.0f / sqrtf(tot * (1.0f / GM_W) + NORM_EPS);
        bf16* dst = Hd + (size_t)(rowc + 64 * th + 16 * tt + fr) * DM + 512 + wid * 64 + 8 * (g & 1) + 16 * (g >> 1);
#pragma unroll
        for (int cp = 0; cp < 2; ++cp) { v2u a, b2;
            a.x = pk2(acc[tt][2 * cp][0] * rstd, acc[tt][2 * cp][1] * rstd); a.y = pk2(acc[tt][2 * cp][2] * rstd, acc[tt][2 * cp][3] * rstd);
            b2.x = pk2(acc[tt][2 * cp + 1][0] * rstd, acc[tt][2 * cp + 1][1] * rstd); b2.y = pk2(acc[tt][2 * cp + 1][2] * rstd, acc[tt][2 * cp + 1][3] * rstd);
            { auto r0 = __builtin_amdgcn_permlane32_swap(a.x, b2.x, false, false); a.x = r0[0]; b2.x = r0[1]; auto r1 = __builtin_amdgcn_permlane32_swap(a.y, b2.y, false, false); a.y = r1[0]; b2.y = r1[1]; }
            *(GAS v4u*)(dst + 32 * cp) = (v4u){a.x, a.y, b2.x, b2.y}; } }
    __syncthreads();
}

#define RLX_AGENT __ATOMIC_RELAXED, __HIP_MEMORY_SCOPE_AGENT
constexpr int CW_BAR = 4096;
#define XB_TMO      128
#define XB_XCNT(j)  (256  + 64 * (j))
#define XB_XSUB(j)  (1280 + 64 * (j))
#define XB_XGEN(j)  (2304 + 64 * (j))
#define XB_TOP      3328
#define XB_TOPGEN   3392
#define XCD_BAR_WORDS 3456
#define XB_SPIN_CAP (1u << 18)

__device__ __forceinline__ unsigned xb_ld(unsigned* p)              { return __hip_atomic_load(p, __ATOMIC_RELAXED, __HIP_MEMORY_SCOPE_AGENT); }
__device__ __forceinline__ unsigned xb_add(unsigned* p, unsigned v) { return __hip_atomic_fetch_add(p, v, __ATOMIC_RELAXED, __HIP_MEMORY_SCOPE_AGENT); }
__device__ __forceinline__ unsigned xb_xcc_id() { return (unsigned)__builtin_amdgcn_s_getreg((3 << 11) | 20) & 0xFu; }
#define XB_SPIN(cond, bar) do { unsigned _sp = 0; while (cond) { __builtin_amdgcn_s_sleep(1); \
    if ((++_sp & 255u) == 0u) { if (xb_ld(&(bar)[XB_TMO])) break; if (_sp > XB_SPIN_CAP) { atomicAdd(&(bar)[XB_TMO], 1u); break; } } } } while (0)

struct XcdBarrier {
    unsigned* bar; unsigned x;
    volatile LAS unsigned* st;
};

__device__ __forceinline__ XcdBarrier xcd_barrier_post(unsigned* bar, volatile LAS unsigned* st) {
    XcdBarrier b; b.bar = bar; b.x = xb_xcc_id(); b.st = st;
    if (threadIdx.x == 0) (void)xb_add(&bar[XB_XCNT(b.x)], 1u);
    return b;
}
__device__ __forceinline__ void xcd_barrier_complete(unsigned* bar, unsigned x, unsigned& nloc, unsigned& nx) {
    const unsigned G = gridDim.x * gridDim.y * gridDim.z;
    unsigned sum, cnt, mine, sp = 0u;
    for (;;) {
        sum = 0u; cnt = 0u; mine = 0u;
#pragma unroll
        for (unsigned j = 0; j < 16; ++j) { const unsigned c = xb_ld(&bar[XB_XCNT(j)]); sum += c; cnt += (c > 0u) ? 1u : 0u; mine = (j == x) ? c : mine; }
        if (sum == G) break;
        __builtin_amdgcn_s_sleep(1);
        if ((++sp & 255u) == 0u) { if (xb_ld(&bar[XB_TMO])) break; if (sp > XB_SPIN_CAP) { atomicAdd(&bar[XB_TMO], 1u); break; } }
    }
    nloc = mine > 0u ? mine : 1u; nx = cnt > 0u ? cnt : 1u;
}

__device__ __forceinline__ void xcd_barrier(const XcdBarrier& b) {
    asm volatile("s_waitcnt vmcnt(0)" ::: "memory");
    __syncthreads();
    if (threadIdx.x == 0) {
        unsigned* bar = b.bar;
        __builtin_amdgcn_s_waitcnt(0);
        unsigned nloc = b.st[0], nx = b.st[1];
        if (nloc == 0u) { xcd_barrier_complete(bar, b.x, nloc, nx); b.st[0] = nloc; b.st[1] = nx; }
        const unsigned old = xb_add(&bar[XB_XSUB(b.x)], 1u);
        const unsigned gen = old / nloc;
        if (old + 1u == (gen + 1u) * nloc) {
            __builtin_amdgcn_fence(__ATOMIC_RELEASE, "agent");
            asm volatile("s_waitcnt vmcnt(0)" ::: "memory");
            const unsigned og = xb_add(&bar[XB_TOP], 1u);
            const unsigned tg = og / nx;
            if (og + 1u == (tg + 1u) * nx) xb_add(&bar[XB_TOPGEN], 1u);
            else XB_SPIN(xb_ld(&bar[XB_TOPGEN]) == tg, bar);
            __builtin_amdgcn_fence(__ATOMIC_ACQUIRE, "agent");
            xb_add(&bar[XB_XGEN(b.x)], 1u);
            asm volatile("s_waitcnt vmcnt(0)" ::: "memory");
        } else {
            XB_SPIN(xb_ld(&bar[XB_XGEN(b.x)]) == gen, bar);
            __builtin_amdgcn_fence(__ATOMIC_ACQUIRE, "agent");
            asm volatile("s_waitcnt vmcnt(0)" ::: "memory");
        }
    }
    __syncthreads();
}

struct TOrder { int c2;
    __device__ __forceinline__ bool next(int i, pg8::Unit& u) const { if (i >= 2) return false; const int idx = c2 + i; u.pm = idx >> 2; u.pn = idx & 3; return true; }
    __device__ __forceinline__ void a_ready(const pg8::Unit&) const {}
    __device__ __forceinline__ void done(const pg8::Unit&) const {} };
#define LAUNDER_S(p) asm volatile("" : "+s"(p))
#define PHASE_PTRS unsigned char* wsl = args.ws; LAUNDER_S(wsl); float* outl = args.out; LAUNDER_S(outl); unsigned* ctl = (unsigned*)(wsl + WS_CTL); (void)ctl; (void)outl; \
    bf16* xn_in = (bf16*)(wsl + ((L & 1) ? WS_XNB : WS_XNA)); bf16* xn_mid = (bf16*)(wsl + ((L & 1) ? WS_XNA : WS_XNB)); (void)xn_in; (void)xn_mid
__global__ void __launch_bounds__(NWAVES * 64, 2) hymba_fwd(Args args) {
    extern __shared__ __attribute__((aligned(16))) unsigned char lds_raw[];
    LAS unsigned char* lds = (LAS unsigned char*)lds_raw;
    cg::grid_group grid = cg::this_grid();
    volatile LAS unsigned* MISC = (volatile LAS unsigned*)(lds + RING_BYTES + 256);
    if (threadIdx.x < 16) MISC[threadIdx.x] = 0u;
    __syncthreads();
    unsigned* barw = (unsigned*)(args.ws + WS_CTL) + CW_BAR; LAUNDER_S(barw);
    const XcdBarrier bar = xcd_barrier_post(barw, MISC + 8);
    if (args.ws == nullptr) grid.sync();
#define GRID_SYNC() xcd_barrier(bar)
    const int G = gridDim.x, bx = blockIdx.x; const int vcu = (G % 8 == 0) ? (bx % 8) * (G / 8) + bx / 8 : bx;

#ifndef NO_PRO
    { int tid_l = threadIdx.x; asm volatile("" : "+v"(tid_l)); const int lane = tid_l & 63; const int wave = __builtin_amdgcn_readfirstlane(tid_l >> 6);
      for (int rep = 0; rep < REP_PRO; ++rep) { p0_prologue(args, lds, vcu, G, wave, lane); if (rep + 1 < REP_PRO) GRID_SYNC(); } }
#endif
    GRID_SYNC();

#pragma unroll 1
    for (int L = 0; L < DEPTH; ++L) {
#if (PHASES & 1)
        {   PHASE_PTRS;
            pg8::Gemm g{xn_in, (const bf16*)(wsl + WS_WIN) + (size_t)L * D_IN * DM, M, D_IN, DM}; pg8::StaticOrder S; S.init(M, D_IN, G, bx);
            pg8::EpiIn E{(bf16*)(wsl + WS_Q), (bf16*)(wsl + WS_K), (bf16*)(wsl + WS_V), (bf16*)(wsl + WS_GU), (bf16*)(wsl + WS_GV), 0.125f * LOG2E};
            for (int rep = 0; rep < REP_P1; ++rep) pg8::gemm_phase<pg8::EpiIn, pg8::StaticOrder, PG8_ALIGN, PG8_SP2>(lds, g, S, E); }
#endif
        if (bx >= 192) { int tid_l = threadIdx.x; asm volatile("" : "+v"(tid_l)); const int lane = tid_l & 63; const int wave = __builtin_amdgcn_readfirstlane(tid_l >> 6);
            const int gw = (bx - 192) * NWAVES + wave, NGW = 64 * NWAVES;
            if (L + 1 < DEPTH) conv_weights(args, L + 1, L + 2, gw, NGW, lane, 1);
            conv_p(args, L, gw * 64 + lane, NGW * 64); }
        GRID_SYNC();
#ifndef NO_ATTN
        {   PHASE_PTRS;
            for (int rep = 0; rep < REP_ATTN; ++rep) for (int u = vcu; u < 256; u += G) attn_unit(u >> 7, u & 127, (const bf16*)(wsl + WS_Q), (const bf16*)(wsl + WS_K), (const bf16*)(wsl + WS_V), (bf16*)(wsl + WS_HEADS), args.in[4] + L * 8, lds); }
#endif
#ifndef NO_GATE
        {   PHASE_PTRS;
            for (int rep = 0; rep < REP_GATE; ++rep) for (int u = vcu; u < 256; u += G) gate_unit(u >> 7, (u & 127) >> 1, u & 1, (const bf16*)(wsl + WS_GU), (const bf16*)(wsl + WS_GV), (bf16*)(wsl + WS_HEADS), (const bf16*)(wsl + WS_WTRIL) + (size_t)L * 8 * 128 * 128,
                                                          args.in[5] + L * GM_W, args.in[6] + L * GM_W, args.in[8] + L * 8 * 128, lds); }
#endif
        GRID_SYNC();
#if (PHASES & 2)
        {   PHASE_PTRS;
            pg8::Gemm g{(const bf16*)(wsl + WS_HEADS), (const bf16*)(wsl + WS_WOUT) + (size_t)L * DM * DM, M, DM, DM}; pg8::StaticOrder S; S.init(M, DM, G, bx);
            const int e0 = L * 5;
            pg8::RmsStats st1{(unsigned*)(wsl + WS_X + (size_t)(e0 + 0) * XBANK_BYTES), ctl + CW_SEAM + (e0 + 0) * SEAM_BANK, NORM_EPS};
            pg8::RmsStats st2{(unsigned*)(wsl + WS_X + (size_t)(e0 + 1) * XBANK_BYTES), ctl + CW_SEAM + (e0 + 1) * SEAM_BANK, NORM_EPS};
            const float* base = (L == 0) ? args.in[0] : (const float*)outl;
#ifdef PROBE_XCHG
            pg8::RmsStats st3{(unsigned*)(wsl + WS_X + (size_t)(20 + 2 * L) * XBANK_BYTES), ctl + CW_SEAM + (20 + 2 * L) * SEAM_BANK, NORM_EPS};
            pg8::EpiRmsResRms E{base, outl, xn_mid, DM, args.in[12] + L * DM, st1, st2, st3};
#else
            pg8::EpiRmsResRms E{base, outl, xn_mid, DM, args.in[12] + L * DM, st1, st2};
#endif
            pg8::gemm_phase<pg8::EpiRmsResRms, pg8::StaticOrder, false, PG8_SP2>(lds, g, S, E); }
#endif
        GRID_SYNC();
#if (PHASES & 4)
        {   PHASE_PTRS;
            pg8::Gemm g{xn_mid, (const bf16*)(wsl + WS_WGU) + (size_t)L * 2 * D_FF * DM, M, 2 * D_FF, DM}; pg8::StaticOrder S; S.init(M, 2 * D_FF, G, bx);
            pg8::EpiSwiGLU E{(bf16*)(wsl + WS_HID), D_FF};
            for (int rep = 0; rep < REP_P4; ++rep) pg8::gemm_phase<pg8::EpiSwiGLU, pg8::StaticOrder, PG8_ALIGN, PG8_SP2>(lds, g, S, E); }
#endif
        if (bx >= 128) { PHASE_PTRS; __syncthreads();
            pg8::Gemm g{(const bf16*)(wsl + WS_PB) + (size_t)L * M * PLE, (const bf16*)(wsl + WS_WP) + (size_t)L * DM * PLE, M, DM, PLE}; TOrder S{(bx - 128) * 2};
            pg8::EpiPlain E{(bf16*)(wsl + WS_T), DM};
            pg8::gemm_phase<pg8::EpiPlain, TOrder, PG8_ALIGN, PG8_SP2>(lds, g, S, E); }
        GRID_SYNC();
#if (PHASES & 8)
        {   PHASE_PTRS;
            pg8::Gemm g{(const bf16*)(wsl + WS_HID), (const bf16*)(wsl + WS_WD) + (size_t)L * DM * D_FF, M, DM, D_FF}; pg8::StaticOrder S; S.init(M, DM, G, bx);
            const int e0 = L * 5 + 2;
            pg8::RmsStats st1{(unsigned*)(wsl + WS_X + (size_t)(e0 + 0) * XBANK_BYTES), ctl + CW_SEAM + (e0 + 0) * SEAM_BANK, NORM_EPS};
            pg8::RmsStats st2{(unsigned*)(wsl + WS_X + (size_t)(e0 + 1) * XBANK_BYTES), ctl + CW_SEAM + (e0 + 1) * SEAM_BANK, NORM_EPS};
#ifdef PROBE_XCHG
            pg8::RmsStats st3{(unsigned*)(wsl + WS_X + (size_t)(21 + 2 * L) * XBANK_BYTES), ctl + CW_SEAM + (21 + 2 * L) * SEAM_BANK, NORM_EPS};
            pg8::EpiRmsResRms E{(const float*)outl, outl, xn_in, DM, args.in[17] + L * DM, st1, st2, st3};
#else
            pg8::EpiRmsResRms E{(const float*)outl, outl, xn_in, DM, args.in[17] + L * DM, st1, st2};
#endif
            pg8::gemm_phase<pg8::EpiRmsResRms, pg8::StaticOrder, false, PG8_SP2>(lds, g, S, E); }
#endif
        GRID_SYNC();
#if (PHASES & 32)
        {   PHASE_PTRS;
            pg8::Gemm g{xn_in, (const bf16*)(wsl + WS_WPG) + (size_t)L * DM * DM, M, DM, DM}; pg8::StaticOrder S; S.init(M, DM, G, bx);
            pg8::RmsStats st{(unsigned*)(wsl + WS_X + (size_t)(L * 5 + 4) * XBANK_BYTES), ctl + CW_SEAM + (L * 5 + 4) * SEAM_BANK, NORM_EPS};
            if (L < DEPTH - 1) { pg8::EpiPle<false> E{(const float*)outl, outl, xn_mid, (const bf16*)(wsl + WS_T), DM, st};
                pg8::gemm_phase<pg8::EpiPle<false>, pg8::StaticOrder, false, PG8_SP2>(lds, g, S, E); }
            else { pg8::EpiPle<true> E{(const float*)outl, outl, xn_mid, (const bf16*)(wsl + WS_T), DM, st};
                pg8::gemm_phase<pg8::EpiPle<true>, pg8::StaticOrder, false, PG8_SP2>(lds, g, S, E); } }
#endif
        for (int rep = 0; rep < EXTRA_SYNC; ++rep) GRID_SYNC();
        if (L < DEPTH - 1) GRID_SYNC();
    }
}

extern "C" void kernel_launch(void* const* d_in, const int* in_sizes, int n_in, void* d_out, int out_size, void* d_ws, size_t ws_size, hipStream_t stream) {
    static int grid = 0;
    if (grid == 0) {
        if (n_in != 21 || in_sizes[0] != M * DM || out_size != M * DM || ws_size < WS_END) { fprintf(stderr, "kernel_launch: shape/workspace mismatch (n_in %d, in0 %d, out %d, ws %zu need %zu)\n", n_in, n_in > 0 ? in_sizes[0] : -1, out_size, ws_size, (size_t)WS_END); grid = -1; return; }
        int dev = 0, cus = 0, per_cu = 0;
        if (hipGetDevice(&dev) != hipSuccess || hipDeviceGetAttribute(&cus, hipDeviceAttributeMultiprocessorCount, dev) != hipSuccess) { grid = -1; return; }
        if (hipFuncSetAttribute((const void*)hymba_fwd, hipFuncAttributeMaxDynamicSharedMemorySize, LDS_BYTES) != hipSuccess) { fprintf(stderr, "kernel_launch: hipFuncSetAttribute failed\n"); grid = -1; return; }
        if (hipOccupancyMaxActiveBlocksPerMultiprocessor(&per_cu, (const void*)hymba_fwd, NWAVES * 64, LDS_BYTES) != hipSuccess || per_cu < 1) { fprintf(stderr, "kernel_launch: occupancy query says %d\n", per_cu); per_cu = 1; }
        (void)hipGetLastError();
        grid = cus;
        if (grid != 256) fprintf(stderr, "kernel_launch: %d CUs; the fused epilogues need exactly 256 workgroups\n", grid);
    }
    if (grid < 0) return;
    if (hipMemsetAsync((char*)d_ws + WS_CTL, 0, CTL_ZERO_BYTES, stream) != hipSuccess) { fprintf(stderr, "kernel_launch: memset failed\n"); return; }
    Args a{};
    for (int i = 0; i < 21; ++i) a.in[i] = (const float*)d_in[i];
    a.out = (float*)d_out; a.ws = (unsigned char*)d_ws;
    void* kargs[] = {&a};
    hipError_t e = hipLaunchCooperativeKernel((const void*)hymba_fwd, dim3(grid), dim3(NWAVES * 64), kargs, LDS_BYTES, stream);
    if (e != hipSuccess) fprintf(stderr, "cooperative launch failed: %s (grid %d)\n", hipGetErrorString(e), grid);
}
```

```cpp
#include <hip/hip_runtime.h>
#include <hip/hip_cooperative_groups.h>
#include <cstdio>
#include <cstdint>
namespace cg = cooperative_groups;
namespace pg8 {
#define PG8_LAS __attribute__((address_space(3)))
typedef unsigned short bf16_t;
typedef short bf16x8 __attribute__((ext_vector_type(8)));
typedef float f32x4 __attribute__((ext_vector_type(4)));
typedef unsigned u32x4 __attribute__((ext_vector_type(4)));
constexpr int BM = 256, BK = 64, HALF = 128, HTB = HALF * BK * 2  , STAGE_BYTES = 8 * HTB, NXCD = 8, WGM = 8;

__host__ __device__ __forceinline__ int lds_byte(int r, int c) { const int st = (r >> 4) * 2 + (c >> 5), rr = r & 15, cc = c & 31, ob = rr * 64 + cc * 2; return st * 1024 + (ob ^ (((ob >> 9) & 1) << 5)); }
__host__ __device__ __forceinline__ void stage_rc(int b, int& R, int& C) { const int st = b / 1024, sb = b % 1024, swz = sb ^ (((sb >> 9) & 1) << 5); R = (st >> 1) * 16 + swz / 64; C = (st & 1) * 32 + (swz % 64) / 2; }
__host__ __device__ __forceinline__ int perm32(int rho) { const int n = rho >> 4, i = rho & 15; return 8 * (i >> 2) + 4 * n + (i & 3); }

struct Unit { int pm, pn; };
struct Gemm { const bf16_t* A; const bf16_t* Bt; int M, N, K; };

struct StaticOrder {
    int nM, nN, nwg, G, c;
    __host__ __device__ void init(int M, int N, int G_, int c_) { nM = M / BM; nN = N / BM; nwg = nM * nN; G = G_; c = c_; }
    __host__ __device__ bool next(int i, Unit& u) const {
        const long L = (long)i * G + c; if (L >= nwg) return false;
        int wgid = (int)L; { const int q = nwg / NXCD, r = nwg % NXCD, xcd = wgid % NXCD, off = wgid / NXCD; wgid = (xcd < r ? xcd * (q + 1) : r * (q + 1) + (xcd - r) * q) + off; }
        const int nig = WGM * nN, gid = wgid / nig, fm = gid * WGM, gsz = (nM - fm) < WGM ? (nM - fm) : WGM;
        u.pm = fm + ((wgid % nig) % gsz); u.pn = (wgid % nig) / gsz; return true;
    }
    __device__ __forceinline__ void a_ready(const Unit&) const {}
    __device__ __forceinline__ void done(const Unit&) const {}
};

__device__ __forceinline__ unsigned cvt_pk_bf16(float lo, float hi) { unsigned r; asm volatile("v_cvt_pk_bf16_f32 %0, %1, %2" : "=v"(r) : "v"(lo), "v"(hi)); return r; }
typedef float f32x2 __attribute__((ext_vector_type(2)));
__device__ __forceinline__ f32x2 gelu_pk(f32x2 v) {
    const f32x2 av = __builtin_elementwise_abs(v), d = av * 0.2316418882f + 1.0f;
    f32x2 t; t.x = __builtin_amdgcn_rcpf(d.x); t.y = __builtin_amdgcn_rcpf(d.y);
    f32x2 q = t * 0.5307027145f + (-0.7265760135f); q = q * t + 0.7107068705f; q = q * t + (-0.142248368f); q = q * t + 0.127414796f; q = q * t;
    const f32x2 s = (v * v) * (-0.72134752044f);
    f32x2 e; e.x = __builtin_amdgcn_exp2f(s.x); e.y = __builtin_amdgcn_exp2f(s.y);
    const f32x2 m = v * (q * e), r = v - m;
    f32x2 o; o.x = v.x < 0.f ? m.x : r.x; o.y = v.y < 0.f ? m.y : r.y; return o;
}

template <int ACT  > struct EpiBf16 {
    static constexpr bool PERM = true, AFTER_DRAIN = false; static_assert(ACT == 0 || ACT == 1, "EpiBf16: ACT is 0 (none) or 1 (gelu_pk)");
    bf16_t* O; int ldc; const float* bias; int split_cols; size_t split_stride; float scale0;
    __device__ __forceinline__ void operator()(const f32x4 (&acc)[2][2][4][2], const Unit& u, int wr, int wc, int fr, int fq) const {
        const int row0 = u.pm * BM + wr * 64 + fr; int colt = u.pn * BM; bf16_t* base = O;
        float sc = 1.f; if (split_cols) { const int t = colt / split_cols; base += (size_t)t * split_stride; colt -= t * split_cols; if (t == 0) sc = scale0; }
        const int col0 = colt + wc * 32 + 8 * fq, bcol0 = u.pn * BM + wc * 32 + 8 * fq;
        f32x4 bv[2][2];
#pragma unroll
        for (int bj = 0; bj < 2; ++bj)
#pragma unroll
            for (int n = 0; n < 2; ++n) bv[bj][n] = bias ? *(const f32x4*)(bias + bcol0 + bj * HALF + 4 * n) : (f32x4){0.f, 0.f, 0.f, 0.f};
#pragma unroll
        for (int ai = 0; ai < 2; ++ai)
#pragma unroll
            for (int m = 0; m < 4; ++m) { bf16_t* rowp = base + (size_t)(row0 + ai * HALF + m * 16) * ldc + col0;
#pragma unroll
                for (int bj = 0; bj < 2; ++bj) { f32x4 v0 = acc[ai][bj][m][0] + bv[bj][0], v1 = acc[ai][bj][m][1] + bv[bj][1];
                    if (ACT == 1) { f32x2 a = gelu_pk((f32x2){v0[0], v0[1]}), b = gelu_pk((f32x2){v0[2], v0[3]}), c = gelu_pk((f32x2){v1[0], v1[1]}), d = gelu_pk((f32x2){v1[2], v1[3]});
                        v0 = (f32x4){a.x, a.y, b.x, b.y}; v1 = (f32x4){c.x, c.y, d.x, d.y}; }
                    v0 = v0 * sc; v1 = v1 * sc; u32x4 w; w.x = cvt_pk_bf16(v0[0], v0[1]); w.y = cvt_pk_bf16(v0[2], v0[3]); w.z = cvt_pk_bf16(v1[0], v1[1]); w.w = cvt_pk_bf16(v1[2], v1[3]);
                    *(u32x4*)(rowp + bj * HALF) = w; } }
    }
};

__device__ __forceinline__ float fast_exp2(float x) { return __builtin_amdgcn_exp2f(x); }
__device__ __forceinline__ float fast_rcp(float x) { return __builtin_amdgcn_rcpf(x); }
__device__ __forceinline__ float gelu_tanh(float x) {
    const float u = x * (1.0f + 0.044715f * x * x);
    const float e = fast_exp2(u * (-2.0f * 0.7978845608028654f * 1.4426950408889634f));
    return x * fast_rcp(1.0f + e);
}
__device__ __forceinline__ float sigmoid_f(float x) { return fast_rcp(1.0f + fast_exp2(x * -1.4426950408889634f)); }

struct EpiIn {
    static constexpr bool PERM = true, AFTER_DRAIN = false;
    bf16_t *Q, *Kb, *Vb, *GU, *GV; float qscale;
    __device__ __forceinline__ void operator()(const f32x4 (&acc)[2][2][4][2], const Unit& u, int wr, int wc, int fr, int fq) const {
        const int row0 = u.pm * BM + wr * 64 + fr; const int pn = u.pn; const int cw = wc * 32 + 8 * fq;
#pragma unroll
        for (int ai = 0; ai < 2; ++ai)
#pragma unroll
            for (int m = 0; m < 4; ++m) { const size_t row = (size_t)(row0 + ai * HALF + m * 16);
#pragma unroll
                for (int bj = 0; bj < 2; ++bj) { f32x4 v0 = acc[ai][bj][m][0], v1 = acc[ai][bj][m][1]; bf16_t* dst;
                    if (pn < 2) { v0 = v0 * qscale; v1 = v1 * qscale; dst = Q + row * 512 + pn * 256 + bj * HALF + cw; }
                    else if (pn == 2) { dst = (bj == 0 ? Kb : Vb) + row * 128 + cw; }
                    else { v0 = (f32x4){gelu_tanh(v0[0]), gelu_tanh(v0[1]), gelu_tanh(v0[2]), gelu_tanh(v0[3])}; v1 = (f32x4){gelu_tanh(v1[0]), gelu_tanh(v1[1]), gelu_tanh(v1[2]), gelu_tanh(v1[3])};
                        dst = (pn < 5 ? GU + row * 512 + (pn - 3) * 256 : GV + row * 512 + (pn - 5) * 256) + bj * HALF + cw; }
                    u32x4 w; w.x = cvt_pk_bf16(v0[0], v0[1]); w.y = cvt_pk_bf16(v0[2], v0[3]); w.z = cvt_pk_bf16(v1[0], v1[1]); w.w = cvt_pk_bf16(v1[2], v1[3]);
                    *(u32x4*)dst = w; } }
    }
};
struct EpiPlain {
    static constexpr bool PERM = true, AFTER_DRAIN = false;
    bf16_t* O; int ldc;
    __device__ __forceinline__ void operator()(const f32x4 (&acc)[2][2][4][2], const Unit& u, int wr, int wc, int fr, int fq) const {
        const int row0 = u.pm * BM + wr * 64 + fr; const int col0 = u.pn * BM + wc * 32 + 8 * fq;
#pragma unroll
        for (int ai = 0; ai < 2; ++ai)
#pragma unroll
            for (int m = 0; m < 4; ++m) { bf16_t* dst = O + (size_t)(row0 + ai * HALF + m * 16) * ldc + col0;
#pragma unroll
                for (int bj = 0; bj < 2; ++bj) { const f32x4 v0 = acc[ai][bj][m][0], v1 = acc[ai][bj][m][1];
                    u32x4 w; w.x = cvt_pk_bf16(v0[0], v0[1]); w.y = cvt_pk_bf16(v0[2], v0[3]); w.z = cvt_pk_bf16(v1[0], v1[1]); w.w = cvt_pk_bf16(v1[2], v1[3]);
                    *(u32x4*)(dst + bj * HALF) = w; } }
    }
};
struct EpiSwiGLU {
    static constexpr bool PERM = true, AFTER_DRAIN = false;
    bf16_t* O; int ldc;
    __device__ __forceinline__ void operator()(const f32x4 (&acc)[2][2][4][2], const Unit& u, int wr, int wc, int fr, int fq) const {
        const int row0 = u.pm * BM + wr * 64 + fr; const int col0 = u.pn * HALF + wc * 32 + 8 * fq;
#pragma unroll
        for (int ai = 0; ai < 2; ++ai)
#pragma unroll
            for (int m = 0; m < 4; ++m) { bf16_t* dst = O + (size_t)(row0 + ai * HALF + m * 16) * ldc + col0;
                f32x4 o[2];
#pragma unroll
                for (int n = 0; n < 2; ++n) { const f32x4 g = acc[ai][0][m][n], up = acc[ai][1][m][n];
#pragma unroll
                    for (int j = 0; j < 4; ++j) o[n][j] = g[j] * sigmoid_f(g[j]) * up[j]; }
                u32x4 w; w.x = cvt_pk_bf16(o[0][0], o[0][1]); w.y = cvt_pk_bf16(o[0][2], o[0][3]); w.z = cvt_pk_bf16(o[1][0], o[1][1]); w.w = cvt_pk_bf16(o[1][2], o[1][3]);
                *(u32x4*)dst = w; }
    }
};

struct RmsStats {
    unsigned* xbuf;
    unsigned* cnt;
    float eps;
    __device__ __forceinline__ void run(const f32x4 (&v)[2][2][4][2], const Unit& u, int wr, int wc, int fr, int fq, PG8_LAS unsigned char* lds, int wid, int lane) const {
        run_a(v, u, wr, wc, fr, fq, lds, wid, lane); run_b(u, lds, wid, lane); }
    __device__ __forceinline__ void run_a(const f32x4 (&v)[2][2][4][2], const Unit& u, int wr, int wc, int fr, int fq, PG8_LAS unsigned char* lds, int wid, int lane) const {
        PG8_LAS float* P = (PG8_LAS float*)lds;
#pragma unroll
        for (int ai = 0; ai < 2; ++ai)
#pragma unroll
            for (int m = 0; m < 4; ++m) {
                float q = 0.f;
#pragma unroll
                for (int bj = 0; bj < 2; ++bj)
#pragma unroll
                    for (int n = 0; n < 2; ++n) { const f32x4 x = v[ai][bj][m][n]; q += (x[0] * x[0] + x[1] * x[1]) + (x[2] * x[2] + x[3] * x[3]); }
                q += __shfl_xor(q, 16); q += __shfl_xor(q, 32);
                if (fq == 0) P[(ai * HALF + wr * 64 + m * 16 + fr) * 4 + wc] = q;
            }
        asm volatile("s_waitcnt lgkmcnt(0)" ::: "memory"); __builtin_amdgcn_s_barrier(); asm volatile("" ::: "memory");
        const int row = wid * 32 + (lane & 31);
        if (lane < 32) {
            const float t = (P[row * 4 + 0] + P[row * 4 + 1]) + (P[row * 4 + 2] + P[row * 4 + 3]);
            unsigned* slot = xbuf + ((size_t)(u.pm * BM + row) * 4 + u.pn);
            __hip_atomic_store(slot, __float_as_uint(t) | 1u, __ATOMIC_RELAXED, __HIP_MEMORY_SCOPE_AGENT);
        }
    }
    __device__ __forceinline__ void run_b(const Unit& u, PG8_LAS unsigned char* lds, int wid, int lane) const {
        PG8_LAS float* S = (PG8_LAS float*)(lds + 4096);
        const int row = wid * 32 + (lane & 31);
        if (lane < 32) {
            const unsigned* slot = xbuf + (size_t)(u.pm * BM + row) * 4; unsigned a = 0u, b2 = 0u, c = 0u, d = 0u;
            for (unsigned it = 0; it < (1u << 20); ++it) {
                a = __hip_atomic_load(slot + 0, __ATOMIC_RELAXED, __HIP_MEMORY_SCOPE_AGENT); b2 = __hip_atomic_load(slot + 1, __ATOMIC_RELAXED, __HIP_MEMORY_SCOPE_AGENT);
                c = __hip_atomic_load(slot + 2, __ATOMIC_RELAXED, __HIP_MEMORY_SCOPE_AGENT); d = __hip_atomic_load(slot + 3, __ATOMIC_RELAXED, __HIP_MEMORY_SCOPE_AGENT);
                if (__all((a != 0u) & (b2 != 0u) & (c != 0u) & (d != 0u))) break;
                __builtin_amdgcn_s_sleep(1);
            }
            const float s = (__uint_as_float(a) + __uint_as_float(b2)) + (__uint_as_float(c) + __uint_as_float(d));
            S[row] = __builtin_amdgcn_rsqf(s * (1.0f / 1024.0f) + eps);
        }
        asm volatile("s_waitcnt vmcnt(0) lgkmcnt(0)" ::: "memory"); __builtin_amdgcn_s_barrier(); asm volatile("" ::: "memory");
    }
};
constexpr int TAB_OFF = 131072 + 1024;
#define EPI_GLDS(gptr, lds, wid, q) __builtin_amdgcn_global_load_lds((const unsigned*)(gptr), (PG8_LAS unsigned*)((lds) + (wid) * 16384 + (q) * 1024), 16, 0, 0)
#define EPI_LDSV(lds, wid, q, lane) (*(const PG8_LAS f32x4*)((lds) + (wid) * 16384 + (q) * 1024 + (lane) * 16))
struct EpiRmsResRms {
    static constexpr bool PERM = true, AFTER_DRAIN = true;
    const float* base; float* out; bf16_t* xn; int ldc; const float* gpost; RmsStats st1, st2;
#ifdef PROBE_XCHG
    RmsStats st3;
#endif
    __device__ __forceinline__ void fused(f32x4 (&acc)[2][2][4][2], const Unit& u, int wr, int wc, int fr, int fq, PG8_LAS unsigned char* lds, int wid, int lane) const {
        typedef unsigned u32x2v __attribute__((ext_vector_type(2)));
        PG8_LAS unsigned char* tab = lds + TAB_OFF;
        const PG8_LAS float* S = (const PG8_LAS float*)(tab + 4096);
        const int col0 = u.pn * BM + wc * 32 + 8 * fq;
        st1.run_a(acc, u, wr, wc, fr, fq, tab, wid, lane);
#pragma unroll
        for (int m = 0; m < 4; ++m) { const size_t off = (size_t)(u.pm * BM + wr * 64 + m * 16 + fr) * ldc + col0;
#pragma unroll
            for (int bj = 0; bj < 2; ++bj)
#pragma unroll
                for (int n = 0; n < 2; ++n) EPI_GLDS(base + off + bj * HALF + n * 4, lds, wid, m * 4 + bj * 2 + n); }
        f32x4 pre[3][2][2];
#pragma unroll
        for (int m = 0; m < 3; ++m) { const size_t off = (size_t)(u.pm * BM + HALF + wr * 64 + m * 16 + fr) * ldc + col0;
#pragma unroll
            for (int bj = 0; bj < 2; ++bj)
#pragma unroll
                for (int n = 0; n < 2; ++n) pre[m][bj][n] = *(const f32x4*)(base + off + bj * HALF + n * 4); }
        st1.run_b(u, tab, wid, lane);
        f32x4 gv[2][2];
#pragma unroll
        for (int bj = 0; bj < 2; ++bj)
#pragma unroll
            for (int n = 0; n < 2; ++n) gv[bj][n] = *(const f32x4*)(gpost + col0 + bj * HALF + n * 4);
#pragma unroll
        for (int ai = 0; ai < 2; ++ai)
#pragma unroll
            for (int m = 0; m < 4; ++m) { const int r = ai * HALF + wr * 64 + m * 16 + fr; const float sr = S[r]; const size_t off = (size_t)(u.pm * BM + r) * ldc + col0;
#pragma unroll
                for (int bj = 0; bj < 2; ++bj)
#pragma unroll
                    for (int n = 0; n < 2; ++n) { const f32x4 bs = (ai == 0) ? EPI_LDSV(lds, wid, m * 4 + bj * 2 + n, lane) : ((m < 3) ? pre[m < 3 ? m : 0][bj][n] : *(const f32x4*)(base + off + bj * HALF + n * 4));
                        acc[ai][bj][m][n] = bs + (acc[ai][bj][m][n] * sr) * gv[bj][n]; }
                asm volatile("" : "+v"(acc[ai][0][m][0]), "+v"(acc[ai][0][m][1]), "+v"(acc[ai][1][m][0]), "+v"(acc[ai][1][m][1]));
                if (m & 1) asm volatile("" ::: "memory"); }
        st2.run(acc, u, wr, wc, fr, fq, tab, wid, lane);
#ifdef PROBE_XCHG
        st3.run(acc, u, wr, wc, fr, fq, tab, wid, lane);
#endif
#pragma unroll
        for (int ai = 0; ai < 2; ++ai)
#pragma unroll
            for (int m = 0; m < 4; ++m) { const int r = ai * HALF + wr * 64 + m * 16 + fr; const float sr = S[r]; const size_t off = (size_t)(u.pm * BM + r) * ldc + col0;
#pragma unroll
                for (int bj = 0; bj < 2; ++bj) { const f32x4 x0 = acc[ai][bj][m][0], x1 = acc[ai][bj][m][1];
                    *(f32x4*)(out + off + bj * HALF) = x0; *(f32x4*)(out + off + bj * HALF + 4) = x1;
                    const f32x4 o0 = x0 * sr, o1 = x1 * sr; u32x4 w; w.x = cvt_pk_bf16(o0[0], o0[1]); w.y = cvt_pk_bf16(o0[2], o0[3]); w.z = cvt_pk_bf16(o1[0], o1[1]); w.w = cvt_pk_bf16(o1[2], o1[3]);
                    *(u32x4*)(xn + off + bj * HALF) = w; }
                asm volatile("" ::: "memory"); }
    }
};
template <bool LAST> struct EpiPle {
    static constexpr bool PERM = true, AFTER_DRAIN = true;
    const float* base; float* out; bf16_t* xn; const bf16_t* T; int ldc; RmsStats st;
    __device__ __forceinline__ void fused(f32x4 (&acc)[2][2][4][2], const Unit& u, int wr, int wc, int fr, int fq, PG8_LAS unsigned char* lds, int wid, int lane) const {
        typedef unsigned u32x2v __attribute__((ext_vector_type(2)));
        PG8_LAS unsigned char* tab = lds + TAB_OFF;
        const PG8_LAS float* S = (const PG8_LAS float*)(tab + 4096);
        const int col0 = u.pn * BM + wc * 32 + 8 * fq;
#pragma unroll
        for (int m = 0; m < 4; ++m) { const size_t off = (size_t)(u.pm * BM + wr * 64 + m * 16 + fr) * ldc + col0;
#pragma unroll
            for (int bj = 0; bj < 2; ++bj)
#pragma unroll
                for (int n = 0; n < 2; ++n) EPI_GLDS(base + off + bj * HALF + n * 4, lds, wid, m * 4 + bj * 2 + n); }
        u32x4 tpre[4][2];
#pragma unroll
        for (int m = 0; m < 4; ++m) { const size_t off = (size_t)(u.pm * BM + wr * 64 + m * 16 + fr) * ldc + col0;
#pragma unroll
            for (int bj = 0; bj < 2; ++bj) tpre[m][bj] = *(const u32x4*)(T + off + bj * HALF); }
        asm volatile("s_waitcnt vmcnt(0)" ::: "memory"); __builtin_amdgcn_s_barrier(); asm volatile("" ::: "memory");
#pragma unroll
        for (int ai = 0; ai < 2; ++ai)
#pragma unroll
            for (int m = 0; m < 4; ++m) { const int r = ai * HALF + wr * 64 + m * 16 + fr; const size_t off = (size_t)(u.pm * BM + r) * ldc + col0;
#pragma unroll
                for (int bj = 0; bj < 2; ++bj)
#pragma unroll
                    for (int n = 0; n < 2; ++n) { const f32x4 bs = (ai == 0) ? EPI_LDSV(lds, wid, m * 4 + bj * 2 + n, lane) : *(const f32x4*)(base + off + bj * HALF + n * 4); const u32x4 tq = (ai == 0) ? tpre[m][bj] : *(const u32x4*)(T + off + bj * HALF); u32x2v tw; tw.x = n ? tq.z : tq.x; tw.y = n ? tq.w : tq.y;
                        f32x4 tv; tv[0] = __uint_as_float(tw.x << 16); tv[1] = __uint_as_float(tw.x & 0xffff0000u); tv[2] = __uint_as_float(tw.y << 16); tv[3] = __uint_as_float(tw.y & 0xffff0000u);
                        const f32x4 a = acc[ai][bj][m][n]; f32x4 o;
#pragma unroll
                        for (int j = 0; j < 4; ++j) o[j] = bs[j] + tv[j] * sigmoid_f(a[j]);
                        acc[ai][bj][m][n] = o;
                        if (LAST) *(f32x4*)(out + off + bj * HALF + n * 4) = o; }
                asm volatile("" : "+v"(acc[ai][0][m][0]), "+v"(acc[ai][0][m][1]), "+v"(acc[ai][1][m][0]), "+v"(acc[ai][1][m][1]));
                if (m & 1) asm volatile("" ::: "memory"); }
        if (!LAST) {
            st.run(acc, u, wr, wc, fr, fq, tab, wid, lane);
#pragma unroll
            for (int ai = 0; ai < 2; ++ai)
#pragma unroll
                for (int m = 0; m < 4; ++m) { const int r = ai * HALF + wr * 64 + m * 16 + fr; const float sr = S[r]; const size_t off = (size_t)(u.pm * BM + r) * ldc + col0;
#pragma unroll
                    for (int bj = 0; bj < 2; ++bj) { const f32x4 x0 = acc[ai][bj][m][0], x1 = acc[ai][bj][m][1];
                        *(f32x4*)(out + off + bj * HALF) = x0; *(f32x4*)(out + off + bj * HALF + 4) = x1;
                        const f32x4 o0 = x0 * sr, o1 = x1 * sr; u32x4 w; w.x = cvt_pk_bf16(o0[0], o0[1]); w.y = cvt_pk_bf16(o0[2], o0[3]); w.z = cvt_pk_bf16(o1[0], o1[1]); w.w = cvt_pk_bf16(o1[2], o1[3]);
                        *(u32x4*)(xn + off + bj * HALF) = w; }
                    asm volatile("" ::: "memory"); }
        }
    }
};

template <class Epi, class Sched, bool ALIGN_EPI = false, bool SP2 = false>
__device__ __forceinline__ void gemm_phase(PG8_LAS unsigned char* lds, const Gemm g, const Sched& S, const Epi& E) {
    int tid_l = threadIdx.x; asm volatile("" : "+v"(tid_l));
    const int tid = tid_l, wid = __builtin_amdgcn_readfirstlane(tid >> 6), lane = tid & 63, wr = wid >> 2, wc = wid & 3, fr = lane & 15, fq = lane >> 4;
    int K_l = g.K; asm volatile("" : "+s"(K_l));
    const int K = K_l, nt = K / BK;
    unsigned voffA[2], voffB[2];
#pragma unroll
    for (int i = 0; i < 2; ++i) { int R, C; stage_rc(tid * 16 + i * 8192, R, C); const int Rb = Epi::PERM ? ((R & ~31) + perm32(R & 31)) : R;
        voffA[i] = (unsigned)(R * K + C) * 2u; voffB[i] = (unsigned)(Rb * K + C) * 2u; }
    const size_t kstep = (size_t)(BK * 2);
    const size_t hstep = (size_t)HALF * K * 2;
    const size_t tstep = 2 * hstep;
    const unsigned ldsw = (unsigned)wid * 1024u;
    const int aoff = lds_byte(wr * 64 + fr, fq * 8), boff = lds_byte(wc * 32 + fr, fq * 8);
#define PG8_SA(b, h) (((b) * 2 + (h)) * HTB)
#define PG8_SB(b, h) ((4 + (b) * 2 + (h)) * HTB)
#define PG8_STAGE(bufoff, gbase, voff) do { _Pragma("unroll") for (int _i = 0; _i < 2; ++_i) \
        __builtin_amdgcn_global_load_lds((const unsigned*)((const char*)(gbase) + (voff)[_i]), (PG8_LAS unsigned*)(lds + (bufoff) + ldsw + _i * 8192), 16, 0, 0); } while (0)
#define PG8_LDA(dst, b, h) do { _Pragma("unroll") for (int m = 0; m < 4; ++m) _Pragma("unroll") for (int k = 0; k < 2; ++k) dst[m][k] = *(const PG8_LAS bf16x8*)(lds + PG8_SA(b, h) + aoff + m * 2048 + k * 1024); } while (0)
#define PG8_LDB(dst, b, h) do { _Pragma("unroll") for (int n = 0; n < 2; ++n) _Pragma("unroll") for (int k = 0; k < 2; ++k) dst[n][k] = *(const PG8_LAS bf16x8*)(lds + PG8_SB(b, h) + boff + n * 2048 + k * 1024); } while (0)
#define PG8_MMA(ai, bj, At, Bt) do { __builtin_amdgcn_s_setprio(1); _Pragma("unroll") for (int m = 0; m < 4; ++m) _Pragma("unroll") for (int n = 0; n < 2; ++n) _Pragma("unroll") for (int k = 0; k < 2; ++k) \
        acc[ai][bj][m][n] = __builtin_amdgcn_mfma_f32_16x16x32_bf16(Bt[n][k], At[m][k], acc[ai][bj][m][n], 0, 0, 0); __builtin_amdgcn_s_setprio(0); } while (0)
#define PG8_WAIT_V(n) asm volatile("s_waitcnt vmcnt(" #n ")" ::: "memory")
#define PG8_WAIT_L(n) asm volatile("s_waitcnt lgkmcnt(" #n ")" ::: "memory")
#define PG8_BAR __builtin_amdgcn_s_barrier()
#define PG8_SCHED __builtin_amdgcn_sched_barrier(0)
    Unit cur, nxt; int ui = 0;
    if (!S.next(0, cur)) return;
    f32x4 acc[2][2][4][2];
#pragma unroll
    for (int a = 0; a < 2; ++a)
#pragma unroll
        for (int b = 0; b < 2; ++b)
#pragma unroll
            for (int m = 0; m < 4; ++m)
#pragma unroll
                for (int n = 0; n < 2; ++n) acc[a][b][m][n] = (f32x4){0.f, 0.f, 0.f, 0.f};
    bf16x8 At[4][2], B0[2][2], B1[2][2];
    const char* cA = (const char*)g.A + (size_t)cur.pm * tstep; const char* cB = (const char*)g.Bt + (size_t)cur.pn * tstep;
    S.a_ready(cur);
    if constexpr (SP2) {
        PG8_STAGE(PG8_SB(0, 0), cB, voffB); PG8_STAGE(PG8_SB(0, 1), cB + hstep, voffB); PG8_STAGE(PG8_SA(0, 0), cA, voffA); PG8_STAGE(PG8_SA(0, 1), cA + hstep, voffA);
        if (wr == 1) PG8_BAR;
        PG8_WAIT_V(2); PG8_BAR;
        PG8_STAGE(PG8_SB(1, 0), cB + kstep, voffB); PG8_STAGE(PG8_SA(1, 0), cA + kstep, voffA); PG8_STAGE(PG8_SB(1, 1), cB + hstep + kstep, voffB);
        PG8_WAIT_V(6); PG8_BAR;
    } else {
        PG8_STAGE(PG8_SB(0, 0), cB, voffB); PG8_STAGE(PG8_SA(0, 0), cA, voffA); PG8_STAGE(PG8_SB(0, 1), cB + hstep, voffB); PG8_STAGE(PG8_SA(0, 1), cA + hstep, voffA);
        if (wr == 1) PG8_BAR;
        PG8_WAIT_V(4); PG8_BAR;
        PG8_STAGE(PG8_SB(1, 0), cB + kstep, voffB); PG8_STAGE(PG8_SA(1, 0), cA + kstep, voffA); PG8_STAGE(PG8_SB(1, 1), cB + hstep + kstep, voffB);
        PG8_WAIT_V(6); PG8_BAR;
    }
    for (;;) {
        const bool has_next = S.next(ui + 1, nxt);
        const char* nA = has_next ? (const char*)g.A + (size_t)nxt.pm * tstep : cA; const char* nB = has_next ? (const char*)g.Bt + (size_t)nxt.pn * tstep : cB;
        for (int t = 0; t < nt; t += 2) {
            const bool last = (t == nt - 2);
            const char* a1 = cA + (size_t)(t + 1) * kstep;
            const char* a2 = last ? nA : cA + (size_t)(t + 2) * kstep; const char* b2 = last ? nB : cB + (size_t)(t + 2) * kstep;
            const char* a3 = a2 + kstep; const char* b3 = b2 + kstep;
            if (last && has_next) S.a_ready(nxt);
            if constexpr (SP2) {
            PG8_LDB(B0, 0, 0); PG8_LDB(B1, 0, 1); PG8_SCHED; PG8_LDA(At, 0, 0); PG8_STAGE(PG8_SA(1, 1), a1 + hstep, voffA);
            PG8_WAIT_V(8); PG8_WAIT_L(0); PG8_BAR; PG8_MMA(0, 0, At, B0); PG8_MMA(0, 1, At, B1); PG8_BAR; PG8_SCHED;
            PG8_LDA(At, 0, 1); PG8_STAGE(PG8_SB(0, 0), b2, voffB); PG8_STAGE(PG8_SB(0, 1), b2 + hstep, voffB); PG8_STAGE(PG8_SA(0, 0), a2, voffA);
            PG8_WAIT_V(8); PG8_WAIT_L(0); PG8_BAR; PG8_MMA(1, 0, At, B0); PG8_MMA(1, 1, At, B1); PG8_BAR; PG8_SCHED;
            PG8_LDB(B0, 1, 0); PG8_LDB(B1, 1, 1); PG8_SCHED; PG8_LDA(At, 1, 0); PG8_STAGE(PG8_SA(0, 1), a2 + hstep, voffA);
            PG8_WAIT_V(8); PG8_WAIT_L(0); PG8_BAR; PG8_MMA(0, 0, At, B0); PG8_MMA(0, 1, At, B1); PG8_BAR; PG8_SCHED;
            PG8_LDA(At, 1, 1); PG8_STAGE(PG8_SB(1, 0), b3, voffB); PG8_STAGE(PG8_SB(1, 1), b3 + hstep, voffB); PG8_STAGE(PG8_SA(1, 0), a3, voffA);
            PG8_WAIT_V(8); PG8_WAIT_L(0); PG8_BAR; PG8_MMA(1, 0, At, B0); PG8_MMA(1, 1, At, B1); PG8_BAR; PG8_SCHED;
            } else {
            PG8_LDB(B0, 0, 0); PG8_SCHED; PG8_LDA(At, 0, 0); PG8_STAGE(PG8_SA(1, 1), a1 + hstep, voffA);
            PG8_WAIT_L(8); PG8_BAR; PG8_WAIT_L(0); PG8_MMA(0, 0, At, B0); PG8_BAR; PG8_SCHED;
            PG8_LDB(B1, 0, 1); PG8_STAGE(PG8_SB(0, 0), b2, voffB);
            PG8_BAR; PG8_WAIT_L(0); PG8_MMA(0, 1, At, B1); PG8_BAR;
            PG8_LDA(At, 0, 1); PG8_STAGE(PG8_SA(0, 0), a2, voffA);
            PG8_BAR; PG8_WAIT_L(0); PG8_MMA(1, 0, At, B0); PG8_BAR; PG8_SCHED;
            PG8_STAGE(PG8_SB(0, 1), b2 + hstep, voffB);
            PG8_WAIT_V(6); PG8_BAR; PG8_MMA(1, 1, At, B1); PG8_BAR;
            PG8_LDB(B0, 1, 0); PG8_SCHED; PG8_LDA(At, 1, 0); PG8_STAGE(PG8_SA(0, 1), a2 + hstep, voffA);
            PG8_WAIT_L(8); PG8_BAR; PG8_WAIT_L(0); PG8_MMA(0, 0, At, B0); PG8_BAR; PG8_SCHED;
            PG8_LDB(B1, 1, 1); PG8_STAGE(PG8_SB(1, 0), b3, voffB);
            PG8_BAR; PG8_WAIT_L(0); PG8_MMA(0, 1, At, B1); PG8_BAR;
            PG8_LDA(At, 1, 1); PG8_STAGE(PG8_SA(1, 0), a3, voffA);
            PG8_BAR; PG8_WAIT_L(0); PG8_MMA(1, 0, At, B0); PG8_BAR; PG8_SCHED;
            PG8_STAGE(PG8_SB(1, 1), b3 + hstep, voffB);
            PG8_WAIT_V(6); PG8_BAR; PG8_MMA(1, 1, At, B1); PG8_BAR;
            }
        }
        if constexpr (ALIGN_EPI) { if (wr == 0) PG8_BAR; }
        if constexpr (!Epi::AFTER_DRAIN) { E(acc, cur, wr, wc, fr, fq); S.done(cur); }
        if (!has_next) break;
#pragma unroll
        for (int a = 0; a < 2; ++a)
#pragma unroll
            for (int b = 0; b < 2; ++b)
#pragma unroll
                for (int m = 0; m < 4; ++m)
#pragma unroll
                    for (int n = 0; n < 2; ++n) acc[a][b][m][n] = (f32x4){0.f, 0.f, 0.f, 0.f};
        cur = nxt; cA = nA; cB = nB; ++ui;
        if constexpr (ALIGN_EPI) { if (wr == 1) PG8_BAR; }
    }
    PG8_WAIT_V(0);
    if constexpr (!ALIGN_EPI) { if (wr == 0) PG8_BAR; }
    PG8_BAR;
    if constexpr (Epi::AFTER_DRAIN) { E.fused(acc, cur, wr, wc, fr, fq, lds, wid, lane); S.done(cur); }
#undef PG8_SA
#undef PG8_SB
#undef PG8_STAGE
#undef PG8_LDA
#undef PG8_LDB
#undef PG8_MMA
#undef PG8_WAIT_V
#undef PG8_WAIT_L
#undef PG8_BAR
#undef PG8_SCHED
}
}

#ifndef PHASES
#define PHASES 63
#endif
#ifndef REP_ATTN
#define REP_ATTN 1
#endif
#ifndef REP_GATE
#define REP_GATE 1
#endif
#ifndef REP_PRO
#define REP_PRO 1
#endif
#ifndef REP_P1
#define REP_P1 1
#endif
#ifndef REP_P4
#define REP_P4 1
#endif
#ifndef EXTRA_SYNC
#define EXTRA_SYNC 0
#endif
#ifndef PG8_SP2
#define PG8_SP2 true
#endif
#ifndef PG8_ALIGN
#define PG8_ALIGN true
#endif

constexpr int NWAVES = 8;
constexpr int BATCH = 2, SEQ = 8192, DM = 1024, DEPTH = 4;
constexpr int M = BATCH * SEQ;
constexpr int ATTN_W = 512, KV_W = 128, GM_W = 512, D_IN = 1792, D_FF = 2816, PLE = 256;
constexpr float NORM_EPS = 1e-6f;
constexpr float LOG2E = 1.4426950408889634f;

constexpr size_t MiB = 1u << 20;
constexpr size_t WS_CTL = 0, CTL_ZERO_BYTES = 1 * MiB;
constexpr size_t WS_X = 1 * MiB;
constexpr size_t XBANK_BYTES = 256 * 1024;
constexpr size_t WS_WIN = 8 * MiB;
constexpr size_t WS_WOUT = WS_WIN + (size_t)DEPTH * D_IN * DM * 2;
constexpr size_t WS_WGU = WS_WOUT + (size_t)DEPTH * DM * DM * 2;
constexpr size_t WS_WD = WS_WGU + (size_t)DEPTH * 2 * D_FF * DM * 2;
constexpr size_t WS_WP = WS_WD + (size_t)DEPTH * DM * D_FF * 2;
constexpr size_t WS_WPG = WS_WP + (size_t)DEPTH * DM * PLE * 2;
constexpr size_t WS_WTRIL = WS_WPG + (size_t)DEPTH * DM * DM * 2;
constexpr size_t WS_PB = WS_WTRIL + (size_t)DEPTH * 8 * 128 * 128 * 2;
constexpr size_t WS_XNA = WS_PB + (size_t)DEPTH * M * PLE * 2;
constexpr size_t WS_XNB = WS_XNA + (size_t)M * DM * 2;
constexpr size_t WS_OVL = WS_XNB + (size_t)M * DM * 2;
constexpr size_t WS_Q = WS_OVL;
constexpr size_t WS_K = WS_Q + (size_t)M * 512 * 2;
constexpr size_t WS_V = WS_K + (size_t)M * 128 * 2;
constexpr size_t WS_GU = WS_V + (size_t)M * 128 * 2;
constexpr size_t WS_GV = WS_GU + (size_t)M * 512 * 2;
constexpr size_t WS_HEADS = WS_GV + (size_t)M * 512 * 2;
constexpr size_t WS_HID = WS_OVL;
constexpr size_t WS_T = WS_OVL + (size_t)M * D_FF * 2;
constexpr size_t WS_END = WS_T + (size_t)M * DM * 2;
static_assert(WS_HEADS + (size_t)M * DM * 2 <= WS_END, "overlay");
static_assert(WS_X + 28 * XBANK_BYTES <= WS_WIN, "slots");
constexpr int CW_SEAM = 16384, SEAM_BANK = 64 * 64;
static_assert((CW_SEAM + 28 * SEAM_BANK) * 4 <= (int)CTL_ZERO_BYTES, "ctl");

constexpr int RING_BYTES = 131072;
constexpr int LDS_BYTES = 147456;

#define GAS __attribute__((address_space(1)))
#define LAS __attribute__((address_space(3)))
typedef unsigned short bf16;
typedef unsigned v4u __attribute__((ext_vector_type(4)));
typedef unsigned v2u __attribute__((ext_vector_type(2)));
typedef float f32x4 __attribute__((ext_vector_type(4)));
typedef short bf16x8 __attribute__((ext_vector_type(8)));
#define LDS_WAIT() asm volatile("s_waitcnt lgkmcnt(0)" ::: "memory")
__device__ __forceinline__ unsigned f2bf(float f) { unsigned u = __builtin_bit_cast(unsigned, f); return (u + 0x7fffu + ((u >> 16) & 1u)) >> 16; }
__device__ __forceinline__ unsigned pk2(float lo, float hi) { return pg8::cvt_pk_bf16(lo, hi); }
__device__ __forceinline__ float bflo(unsigned w) { return __uint_as_float(w << 16); }
__device__ __forceinline__ float bfhi(unsigned w) { return __uint_as_float(w & 0xffff0000u); }
__device__ __forceinline__ float wave_sum(float v) {
#pragma unroll
    for (int o = 1; o < 64; o <<= 1) v += __shfl_xor(v, o);
    return v;
}

struct Args {
    const float* in[21];
    float* out; unsigned char* ws;
};

__device__ __forceinline__ void p0_transpose_item(const float* W, int K, int N, bf16* WT, int mode, const float* g0, const float* g1, int gsplit, int item, int lane) {
    const int nblk = N / 32, kb = item / nblk, nb = item % nblk, k0 = 64 * kb + 8 * (lane >> 3), n0 = 32 * nb + 4 * (lane & 7);
    f32x4 v[8];
#pragma unroll
    for (int i = 0; i < 8; ++i) v[i] = __builtin_nontemporal_load((const GAS f32x4*)(W + (size_t)(k0 + i) * N + n0));
    if (g0) { const float* gp = g0 + k0; if (k0 >= gsplit) gp = g1 + (k0 - gsplit);
        const f32x4 ga = *(const GAS f32x4*)gp, gb = *(const GAS f32x4*)(gp + 4);
        v[0] = v[0] * ga.x; v[1] = v[1] * ga.y; v[2] = v[2] * ga.z; v[3] = v[3] * ga.w; v[4] = v[4] * gb.x; v[5] = v[5] * gb.y; v[6] = v[6] * gb.z; v[7] = v[7] * gb.w; }
#pragma unroll
    for (int j = 0; j < 4; ++j) { const int ns = n0 + j; const int row = (mode == 0) ? ns : ((ns >> 7) * 256 + (mode == 2 ? 128 : 0) + (ns & 127));
        v4u o; o.x = pk2(v[0][j], v[1][j]); o.y = pk2(v[2][j], v[3][j]); o.z = pk2(v[4][j], v[5][j]); o.w = pk2(v[6][j], v[7][j]);
        *(GAS v4u*)(WT + (size_t)row * K + k0) = o; }
}
__device__ __forceinline__ void rms_row_to_bf16(const float* xrow, bf16* orow, int lane) {
    const GAS f32x4* xr = (const GAS f32x4*)xrow + 2 * lane;
    f32x4 v[4]; float s = 0.f;
#pragma unroll
    for (int j = 0; j < 2; ++j) { v[2 * j] = __builtin_nontemporal_load(xr + 128 * j); v[2 * j + 1] = __builtin_nontemporal_load(xr + 128 * j + 1); }
#pragma unroll
    for (int j = 0; j < 4; ++j) s += (v[j].x * v[j].x + v[j].y * v[j].y) + (v[j].z * v[j].z + v[j].w * v[j].w);
    const float rstd = __builtin_amdgcn_rsqf(wave_sum(s) * (1.f / DM) + NORM_EPS);
    GAS v4u* o16 = (GAS v4u*)orow + lane;
#pragma unroll
    for (int j = 0; j < 2; ++j) { v4u o; o.x = pk2(v[2 * j].x * rstd, v[2 * j].y * rstd); o.y = pk2(v[2 * j].z * rstd, v[2 * j].w * rstd); o.z = pk2(v[2 * j + 1].x * rstd, v[2 * j + 1].y * rstd); o.w = pk2(v[2 * j + 1].z * rstd, v[2 * j + 1].w * rstd);
        o16[64 * j] = o; }
}
__device__ __forceinline__ void conv_weights(const Args& A, int l_lo, int l_hi, int gw, int NGW, int lane, int which) {
    unsigned char* ws = A.ws;
    const float* ln_mix_pre = A.in[2]; const float* w_in = A.in[3];
    const float* g_attn_out = A.in[9]; const float* g_gm_out = A.in[10]; const float* w_out = A.in[11];
    const float* ln_ffn_pre = A.in[13]; const float* w_gate = A.in[14]; const float* w_up = A.in[15]; const float* w_down = A.in[16];
    const float* w_ple = A.in[18]; const float* ln_ple_gate = A.in[19]; const float* w_pg = A.in[20];
    constexpr int I_IN = (DM / 64) * (D_IN / 32), I_OUT = (DM / 64) * (DM / 32), I_G = (DM / 64) * (D_FF / 32), I_D = (D_FF / 64) * (DM / 32), I_P = (PLE / 64) * (DM / 32), I_PG = I_OUT;
    constexpr int PER_LAYER = I_IN + I_OUT + 2 * I_G + I_D + I_P + I_PG;
    for (int it = l_lo * PER_LAYER + gw; it < l_hi * PER_LAYER; it += NGW) {
        const int L = it / PER_LAYER; int r = it % PER_LAYER;
        { const bool ffn = (r >= I_IN + I_OUT) && (r < I_IN + I_OUT + 2 * I_G + I_D); if ((which == 1 && ffn) || (which == 2 && !ffn)) continue; }
        const float* W; int K, N, mode = 0, gsplit = 1 << 30; bf16* WT; const float* g0; const float* g1;
        if (r < I_IN) { W = w_in + (size_t)L * DM * D_IN; K = DM; N = D_IN; WT = (bf16*)(ws + WS_WIN) + (size_t)L * D_IN * DM; g0 = ln_mix_pre + L * DM; g1 = g0; }
        else if ((r -= I_IN) < I_OUT) { W = w_out + (size_t)L * DM * DM; K = DM; N = DM; WT = (bf16*)(ws + WS_WOUT) + (size_t)L * DM * DM; g0 = g_attn_out + L * 512; g1 = g_gm_out + L * 512; gsplit = 512; }
        else if ((r -= I_OUT) < I_G) { W = w_gate + (size_t)L * DM * D_FF; K = DM; N = D_FF; WT = (bf16*)(ws + WS_WGU) + (size_t)L * 2 * D_FF * DM; mode = 1; g0 = ln_ffn_pre + L * DM; g1 = g0; }
        else if ((r -= I_G) < I_G) { W = w_up + (size_t)L * DM * D_FF; K = DM; N = D_FF; WT = (bf16*)(ws + WS_WGU) + (size_t)L * 2 * D_FF * DM; mode = 2; g0 = ln_ffn_pre + L * DM; g1 = g0; }
        else if ((r -= I_G) < I_D) { W = w_down + (size_t)L * D_FF * DM; K = D_FF; N = DM; WT = (bf16*)(ws + WS_WD) + (size_t)L * DM * D_FF; g0 = nullptr; g1 = nullptr; }
        else if ((r -= I_D) < I_P) { W = w_ple + (size_t)L * PLE * DM; K = PLE; N = DM; WT = (bf16*)(ws + WS_WP) + (size_t)L * DM * PLE; g0 = nullptr; g1 = nullptr; }
        else { r -= I_P; W = w_pg + (size_t)L * DM * DM; K = DM; N = DM; WT = (bf16*)(ws + WS_WPG) + (size_t)L * DM * DM; g0 = ln_ple_gate + L * DM; g1 = g0; }
        p0_transpose_item(W, K, N, WT, mode, g0, g1, gsplit, r, lane);
    }
}
__device__ __forceinline__ void conv_p(const Args& A, int L, int gt, int NT) {
    const float* p = A.in[1] + (size_t)L * M * PLE; bf16* pb = (bf16*)(A.ws + WS_PB) + (size_t)L * M * PLE;
    for (int i = gt; i < M * PLE / 8; i += NT) { const size_t e0 = (size_t)i * 8;
        const f32x4 a = __builtin_nontemporal_load((const GAS f32x4*)(p + e0)), b = __builtin_nontemporal_load((const GAS f32x4*)(p + e0 + 4));
        v4u o; o.x = pk2(a.x, a.y); o.y = pk2(a.z, a.w); o.z = pk2(b.x, b.y); o.w = pk2(b.z, b.w);
        *(GAS v4u*)(pb + e0) = o; }
}
__device__ __forceinline__ void p0_prologue(const Args& A, LAS unsigned char* lds, int vcu, int G, int wave, int lane) {
    (void)lds;
    const int gw = vcu * NWAVES + wave, NGW = G * NWAVES;
    unsigned char* ws = A.ws; const float* gm_ws = A.in[7];
    conv_weights(A, 0, 1, gw, NGW, lane, 0);
    conv_weights(A, 1, DEPTH, gw, NGW, lane, 2);
    { const int gt = gw * 64 + lane, NT = NGW * 64;
      for (int i = gt; i < DEPTH * 8 * 128 * 128 / 8; i += NT) { const int e0 = i * 8; const int t = (e0 >> 7) & 127, s0 = e0 & 127;
          const f32x4 a = *(const GAS f32x4*)(gm_ws + e0), b = *(const GAS f32x4*)(gm_ws + e0 + 4);
          v4u o; o.x = pk2(s0 + 0 <= t ? a.x : 0.f, s0 + 1 <= t ? a.y : 0.f); o.y = pk2(s0 + 2 <= t ? a.z : 0.f, s0 + 3 <= t ? a.w : 0.f);
          o.z = pk2(s0 + 4 <= t ? b.x : 0.f, s0 + 5 <= t ? b.y : 0.f); o.w = pk2(s0 + 6 <= t ? b.z : 0.f, s0 + 7 <= t ? b.w : 0.f);
          *(GAS v4u*)((bf16*)(ws + WS_WTRIL) + e0) = o; } }
    for (int m = gw; m < M; m += NGW) rms_row_to_bf16(A.in[0] + (size_t)m * DM, (bf16*)(ws + WS_XNA) + (size_t)m * DM, lane);
    { const int gt = gw * 64 + lane, NT = NGW * 64; for (int i = gt; i < (int)(20 * XBANK_BYTES / 16); i += NT) *(GAS v4u*)(ws + WS_X + (size_t)i * 16) = (v4u){0u, 0u, 0u, 0u}; }
}

constexpr int KS_STRIDE = 72, VT_STRIDE = 200;
constexpr int ALDS_KS = 0;
constexpr int ALDS_VT = 55296;
constexpr int ALDS_RED = 106496;
__device__ __forceinline__ void attn_unit(int b, int qb, const bf16* Qg, const bf16* Kg, const bf16* Vg, bf16* Hd, const float* sinks, LAS unsigned char* lds) {
    int tid_l = threadIdx.x; asm volatile("" : "+v"(tid_l));
    const int tid = tid_l, lane = tid & 63, fr = lane & 15, g = lane >> 4; const int wid = __builtin_amdgcn_readfirstlane(tid >> 6);
    const long rowb = (long)b * SEQ; const int t0 = qb * 64, j0 = t0 - 128;
    const int hq = wid, kvh = hq >> 2;
    const float slope2 = __builtin_amdgcn_exp2f(-(float)(hq + 1)) * LOG2E;
    const float sink2 = sinks[hq] * LOG2E;
    bf16x8 qf[4][2];
#pragma unroll
    for (int qt = 0; qt < 4; ++qt)
#pragma unroll
        for (int ds = 0; ds < 2; ++ds) qf[qt][ds] = *(const GAS bf16x8*)(Qg + (size_t)(rowb + t0 + 16 * qt + fr) * ATTN_W + hq * 64 + 32 * ds + 8 * g);
#ifndef REP_ASTAGE
#define REP_ASTAGE 1
#endif
#ifndef REP_ACOMP
#define REP_ACOMP 1
#endif
    for (int rs_ = 0; rs_ < REP_ASTAGE; ++rs_) { if (rs_) __syncthreads();
#pragma unroll
    for (int it = 0; it < 6; ++it) { const int idx = it * 512 + tid; const int key = idx >> 4, c = idx & 15; const int j = j0 + key;
        v4u v = (v4u){0u, 0u, 0u, 0u}; if (j >= 0) v = *(const GAS v4u*)(Kg + (size_t)(rowb + j) * KV_W + c * 8);
        const int kvh = c >> 3, d0 = (c & 7) * 8;
        *(LAS v4u*)(lds + ALDS_KS + ((kvh * 192 + key) * KS_STRIDE + d0) * 2) = v; }
#pragma unroll
    for (int it = 0; it < 3; ++it) { const int idx = it * 512 + tid; const int kp = idx % 96, c = idx / 96; const int j = j0 + 2 * kp;
        v4u va = (v4u){0u, 0u, 0u, 0u}, vb = (v4u){0u, 0u, 0u, 0u};
        if (j >= 0) { va = *(const GAS v4u*)(Vg + (size_t)(rowb + j) * KV_W + c * 8); vb = *(const GAS v4u*)(Vg + (size_t)(rowb + j + 1) * KV_W + c * 8); }
        const int kvh = c >> 3, d0 = (c & 7) * 8;
        LAS unsigned char* dst = lds + ALDS_VT + ((kvh * 64 + d0) * VT_STRIDE + 2 * kp) * 2;
#pragma unroll
        for (int w = 0; w < 4; ++w) { const unsigned a = va[w], bb = vb[w];
            *(LAS unsigned*)(dst + (2 * w) * VT_STRIDE * 2) = (a & 0xffffu) | (bb << 16);
            *(LAS unsigned*)(dst + (2 * w + 1) * VT_STRIDE * 2) = (a >> 16) | (bb & 0xffff0000u); } }
    }
    __syncthreads();
    LAS float* red = (LAS float*)(lds + ALDS_RED);
    const LAS unsigned char* ksb = lds + ALDS_KS + ((kvh * 192 + fr) * KS_STRIDE + 8 * g) * 2;
    const int frp = 8 * ((fr >> 2) & 1) + 4 * (fr >> 3) + (fr & 3);
    const LAS unsigned char* vtb = lds + ALDS_VT + ((kvh * 64 + frp) * VT_STRIDE + 4 * g) * 2;
    f32x4 o[4][4];
    const int l0 = fr - 4 * g; const float nslope2 = -slope2, nb = nslope2 * (float)l0; const int kinv = (-j0) >> 4;
#pragma unroll
    for (int p = 0; p < 2; ++p) {
        const int kt0 = 2 * p;
        f32x4 s[2][10];
#pragma unroll
        for (int kk = 0; kk < 10; ++kk) {
#pragma unroll
            for (int q = 0; q < 2; ++q) {
                if (kk < q || kk > q + 8) s[q][kk] = (f32x4){0.f, 0.f, 0.f, 0.f};
                else {
#pragma unroll
                    for (int r = 0; r < 4; ++r) s[q][kk][r] = __builtin_fmaf(nslope2, (float)(16 * (2 * p + q) + 128 - 16 * (kt0 + kk) - r), nb); } }
#pragma unroll
            for (int ds = 0; ds < 2; ++ds) { const bf16x8 kf = *(const LAS bf16x8*)(ksb + ((kt0 + kk) * 16 * KS_STRIDE + 32 * ds) * 2);
                if (kk <= 8) s[0][kk] = __builtin_amdgcn_mfma_f32_16x16x32_bf16(kf, qf[2 * p][ds], s[0][kk], 0, 0, 0);
                if (kk >= 1) s[1][kk] = __builtin_amdgcn_mfma_f32_16x16x32_bf16(kf, qf[2 * p + 1][ds], s[1][kk], 0, 0, 0); } }
        float inv[2];
#pragma unroll
        for (int q = 0; q < 2; ++q) {
            const int klo = q;
#pragma unroll
            for (int r = 0; r < 4; ++r) { const bool lo_ok = (l0 - r) < 0; s[q][klo][r] = lo_ok ? s[q][klo][r] : -1e30f; s[q][klo + 8][r] = lo_ok ? -1e30f : s[q][klo + 8][r]; }
            if (kinv > 0) {
#pragma unroll
                for (int kk = 0; kk < 10; ++kk) if (kk >= klo && kk <= klo + 8 && kt0 + kk < kinv) s[q][kk] = (f32x4){-1e30f, -1e30f, -1e30f, -1e30f};
            }
            float mx = sink2;
#pragma unroll
            for (int kk = 0; kk < 10; ++kk) if (kk >= klo && kk <= klo + 8) mx = fmaxf(fmaxf(mx, fmaxf(s[q][kk][0], s[q][kk][1])), fmaxf(s[q][kk][2], s[q][kk][3]));
            mx = fmaxf(mx, __shfl_xor(mx, 16)); mx = fmaxf(mx, __shfl_xor(mx, 32));
            float sum = 0.f;
#pragma unroll
            for (int kk = 0; kk < 10; ++kk) if (kk >= klo && kk <= klo + 8) {
#pragma unroll
                for (int r = 0; r < 4; ++r) { const float e = __builtin_amdgcn_exp2f(s[q][kk][r] - mx); s[q][kk][r] = e; sum += e; } }
            sum += __shfl_xor(sum, 16); sum += __shfl_xor(sum, 32);
            inv[q] = __builtin_amdgcn_rcpf(sum + __builtin_amdgcn_exp2f(sink2 - mx));
#pragma unroll
            for (int dt = 0; dt < 4; ++dt) o[2 * p + q][dt] = (f32x4){0.f, 0.f, 0.f, 0.f};
        }
#pragma unroll
        for (int kp = 0; kp < 5; ++kp) {
            bf16x8 pb[2];
#pragma unroll
            for (int q = 0; q < 2; ++q) { v4u pw; pw.x = pk2(s[q][2 * kp][0], s[q][2 * kp][1]); pw.y = pk2(s[q][2 * kp][2], s[q][2 * kp][3]); pw.z = pk2(s[q][2 * kp + 1][0], s[q][2 * kp + 1][1]); pw.w = pk2(s[q][2 * kp + 1][2], s[q][2 * kp + 1][3]);
                pb[q] = __builtin_bit_cast(bf16x8, pw); }
#pragma unroll
            for (int dt = 0; dt < 4; ++dt) { const LAS unsigned char* vp = vtb + (dt * 16 * VT_STRIDE + 16 * (kt0 + 2 * kp)) * 2;
                const v2u lo = *(const LAS v2u*)vp, hi = *(const LAS v2u*)(vp + 32);
                const bf16x8 vf = __builtin_bit_cast(bf16x8, ((v4u){lo.x, lo.y, hi.x, hi.y}));
                o[2 * p][dt] = __builtin_amdgcn_mfma_f32_16x16x32_bf16(vf, pb[0], o[2 * p][dt], 0, 0, 0);
                o[2 * p + 1][dt] = __builtin_amdgcn_mfma_f32_16x16x32_bf16(vf, pb[1], o[2 * p + 1][dt], 0, 0, 0); } }
#pragma unroll
        for (int q = 0; q < 2; ++q) { const int qt = 2 * p + q; float ss = 0.f;
#pragma unroll
            for (int dt = 0; dt < 4; ++dt) { o[qt][dt] = o[qt][dt] * inv[q]; ss += (o[qt][dt][0] * o[qt][dt][0] + o[qt][dt][1] * o[qt][dt][1]) + (o[qt][dt][2] * o[qt][dt][2] + o[qt][dt][3] * o[qt][dt][3]); }
            ss += __shfl_xor(ss, 16); ss += __shfl_xor(ss, 32);
            if (g == 0) red[wid * 64 + 16 * qt + fr] = ss; }
    }
    __syncthreads();
#pragma unroll
    for (int qt = 0; qt < 4; ++qt) { float tot = 0.f;
#pragma unroll
        for (int w = 0; w < 8; ++w) tot += red[w * 64 + 16 * qt + fr];
        const float rstd = __builtin_amdgcn_rsqf(tot * (1.0f / ATTN_W) + NORM_EPS);
        bf16* dst = Hd + (size_t)(rowb + t0 + 16 * qt + fr) * DM + hq * 64 + 8 * (g & 1) + 16 * (g >> 1);
#pragma unroll
        for (int dp = 0; dp < 2; ++dp) { v2u a, b2;
            a.x = pk2(o[qt][2 * dp][0] * rstd, o[qt][2 * dp][1] * rstd); a.y = pk2(o[qt][2 * dp][2] * rstd, o[qt][2 * dp][3] * rstd);
            b2.x = pk2(o[qt][2 * dp + 1][0] * rstd, o[qt][2 * dp + 1][1] * rstd); b2.y = pk2(o[qt][2 * dp + 1][2] * rstd, o[qt][2 * dp + 1][3] * rstd);
            { auto r0 = __builtin_amdgcn_permlane32_swap(a.x, b2.x, false, false); a.x = r0[0]; b2.x = r0[1]; auto r1 = __builtin_amdgcn_permlane32_swap(a.y, b2.y, false, false); a.y = r1[0]; b2.y = r1[1]; }
            *(GAS v4u*)(dst + 32 * dp) = (v4u){a.x, a.y, b2.x, b2.y}; } }
    __syncthreads();
}

constexpr int GLDS_LN = 0;
constexpr int GLDS_P1 = 73728, GLDS_P2 = 75776, GLDS_RED = 77824;
__device__ __forceinline__ void gate_unit(int b, int c, int th, const bf16* GUg, const bf16* GVg, bf16* Hd, const bf16* Wt, const float* lng, const float* lnb, const float* bs, LAS unsigned char* lds) {
    int tid_l = threadIdx.x; asm volatile("" : "+v"(tid_l));
    const int tid = tid_l, lane = tid & 63, fr = lane & 15, g = lane >> 4; const int wid = __builtin_amdgcn_readfirstlane(tid >> 6);
    const long rowc = (long)b * SEQ + c * 128;
    LAS unsigned char* lnw = lds + GLDS_LN + wid * 9216;
    LAS float* p1 = (LAS float*)(lds + GLDS_P1); LAS float* p2 = (LAS float*)(lds + GLDS_P2); LAS float* red = (LAS float*)(lds + GLDS_RED);
    const bf16* Wh = Wt + (size_t)wid * 128 * 128;
    const int frp = 8 * ((fr >> 2) & 1) + 4 * (fr >> 3) + (fr & 3);
    f32x4 acc[4][4];
#pragma unroll
    for (int tt = 0; tt < 4; ++tt)
#pragma unroll
        for (int ct = 0; ct < 4; ++ct) acc[tt][ct] = (f32x4){0.f, 0.f, 0.f, 0.f};
    v4u xa[8];
    const bf16* src0 = GVg + (size_t)(rowc + lane) * GM_W + wid * 64;
#pragma unroll
    for (int i = 0; i < 8; ++i) xa[i] = *(const GAS v4u*)(src0 + 8 * i);
    for (int sh = 0; sh <= th; ++sh) {
        float sm = 0.f;
#define x xa
#pragma unroll
        for (int i = 0; i < 8; ++i) {
#pragma unroll
            for (int w = 0; w < 4; ++w) sm += bflo(x[i][w]) + bfhi(x[i][w]); }
        bf16x8 wfr[4][2];
#pragma unroll
        for (int tt = 0; tt < 4; ++tt)
#pragma unroll
            for (int ks = 0; ks < 2; ++ks) wfr[tt][ks] = *(const GAS bf16x8*)(Wh + (size_t)(64 * th + 16 * tt + fr) * 128 + 64 * sh + 32 * ks + 8 * g);
        p1[wid * 64 + lane] = sm;
        __syncthreads();
        float tot = 0.f;
#pragma unroll
        for (int w = 0; w < 8; ++w) tot += p1[w * 64 + lane];
        const float mean = tot * (1.0f / GM_W);
        float sq = 0.f;
#pragma unroll
        for (int i = 0; i < 8; ++i)
#pragma unroll
            for (int w = 0; w < 4; ++w) { const float a = bflo(x[i][w]) - mean, bb = bfhi(x[i][w]) - mean; sq += a * a + bb * bb; }
        p2[wid * 64 + lane] = sq;
        __syncthreads();
        float tq = 0.f;
#pragma unroll
        for (int w = 0; w < 8; ++w) tq += p2[w * 64 + lane];
        const float rstd = __builtin_amdgcn_rsqf(tq * (1.0f / GM_W) + NORM_EPS);
#pragma unroll
        for (int i = 0; i < 8; ++i)
#pragma unroll
            for (int w = 0; w < 4; ++w) { const int f = 8 * i + 2 * w;
                const float y0 = (bflo(x[i][w]) - mean) * rstd * lng[wid * 64 + f] + lnb[wid * 64 + f];
                const float y1 = (bfhi(x[i][w]) - mean) * rstd * lng[wid * 64 + f + 1] + lnb[wid * 64 + f + 1];
                const unsigned yw = pk2(y0, y1);
                *(LAS unsigned short*)(lnw + (f * 72 + lane) * 2) = (unsigned short)(yw & 0xffffu);
                *(LAS unsigned short*)(lnw + ((f + 1) * 72 + lane) * 2) = (unsigned short)(yw >> 16); }
        LDS_WAIT(); asm volatile("" ::: "memory");
        if (sh < th) {
#pragma unroll
            for (int i = 0; i < 8; ++i) xa[i] = *(const GAS v4u*)(src0 + (size_t)64 * GM_W + 8 * i); }
#pragma unroll
        for (int tt = 0; tt < 4; ++tt)
#pragma unroll
            for (int ks = 0; ks < 2; ++ks) {
                if (64 * sh + 32 * ks <= 64 * th + 16 * tt + 15) {
                    const bf16x8 wf = wfr[tt][ks];
#pragma unroll
                    for (int ct = 0; ct < 4; ++ct) { const bf16x8 af = *(const LAS bf16x8*)(lnw + ((16 * ct + frp) * 72 + 32 * ks + 8 * g) * 2);
                        acc[tt][ct] = __builtin_amdgcn_mfma_f32_16x16x32_bf16(af, wf, acc[tt][ct], 0, 0, 0); }
                }
            }
        LDS_WAIT(); asm volatile("" ::: "memory");
    }
#undef x
#pragma unroll
    for (int tt = 0; tt < 4; ++tt) { const int tl = 64 * th + 16 * tt + fr; const float bsv = bs[wid * 128 + tl]; float ss = 0.f;
        const bf16* gsrc = GUg + (size_t)(rowc + tl) * GM_W + wid * 64 + 8 * (g & 1) + 16 * (g >> 1);
        v2u gws[4];
#pragma unroll
        for (int cp = 0; cp < 2; ++cp) { const v4u q = *(const GAS v4u*)(gsrc + 32 * cp); v2u a = (v2u){q.x, q.y}, b2 = (v2u){q.z, q.w};
            auto r0 = __builtin_amdgcn_permlane32_swap(a.x, b2.x, false, false); a.x = r0[0]; b2.x = r0[1]; auto r1 = __builtin_amdgcn_permlane32_swap(a.y, b2.y, false, false); a.y = r1[0]; b2.y = r1[1];
            gws[2 * cp] = a; gws[2 * cp + 1] = b2; }
#pragma unroll
        for (int ct = 0; ct < 4; ++ct) { const v2u gw = gws[ct];
            f32x4 v = acc[tt][ct]; v[0] = bflo(gw.x) * (v[0] + bsv); v[1] = bfhi(gw.x) * (v[1] + bsv); v[2] = bflo(gw.y) * (v[2] + bsv); v[3] = bfhi(gw.y) * (v[3] + bsv);
            acc[tt][ct] = v; ss += (v[0] * v[0] + v[1] * v[1]) + (v[2] * v[2] + v[3] * v[3]); }
        ss += __shfl_xor(ss, 16); ss += __shfl_xor(ss, 32);
        if (g == 0) red[wid * 64 + 16 * tt + fr] = ss; }
    __syncthreads();
#pragma unroll
    for (int tt = 0; tt < 4; ++tt) { float tot = 0.f;
#pragma unroll
        for (int w = 0; w < 8; ++w) tot += red[w * 64 + 16 * tt + fr];
        const float rstd = __builtin_amdgcn_rsqf(tot * (1.0f / GM_W) + NORM_EPS);
        bf16* dst = Hd + (size_t)(rowc + 64 * th + 16 * tt + fr) * DM + 512 + wid * 64 + 8 * (g & 1) + 16 * (g >> 1);
#pragma unroll
        for (int cp = 0; cp < 2; ++cp) { v2u a, b2;
            a.x = pk2(acc[tt][2 * cp][0] * rstd, acc[tt][2 * cp][1] * rstd); a.y = pk2(acc[tt][2 * cp][2] * rstd, acc[tt][2 * cp][3] * rstd);
            b2.x = pk2(acc[tt][2 * cp + 1][0] * rstd, acc[tt][2 * cp + 1][1] * rstd); b2.y = pk2(acc[tt][2 * cp + 1][2] * rstd, acc[tt][2 * cp + 1][3] * rstd);
            { auto r0 = __builtin_amdgcn_permlane32_swap(a.x, b2.x, false, false); a.x = r0[0]; b2.x = r0[1]; auto r1 = __builtin_amdgcn_permlane32_swap(a.y, b2.y, false, false); a.y = r1[0]; b2.y = r1[1]; }
            *(GAS v4u*)(dst + 32 * cp) = (v4u){a.x, a.y, b2.x, b2.y}; } }
    __syncthreads();
}

#define RLX_AGENT __ATOMIC_RELAXED, __HIP_MEMORY_SCOPE_AGENT
constexpr int CW_BAR = 4096;
#define XB_TMO      128
#define XB_XCNT(j)  (256  + 64 * (j))
#define XB_XSUB(j)  (1280 + 64 * (j))
#define XB_XGEN(j)  (2304 + 64 * (j))
#define XB_TOP      3328
#define XB_TOPGEN   3392
#define XCD_BAR_WORDS 3456
#define XB_SPIN_CAP (1u << 18)

__device__ __forceinline__ unsigned xb_ld(unsigned* p)              { return __hip_atomic_load(p, __ATOMIC_RELAXED, __HIP_MEMORY_SCOPE_AGENT); }
__device__ __forceinline__ unsigned xb_add(unsigned* p, unsigned v) { return __hip_atomic_fetch_add(p, v, __ATOMIC_RELAXED, __HIP_MEMORY_SCOPE_AGENT); }
__device__ __forceinline__ unsigned xb_xcc_id() { return (unsigned)__builtin_amdgcn_s_getreg((3 << 11) | 20) & 0xFu; }
#define XB_SPIN(cond, bar) do { unsigned _sp = 0; while (cond) { __builtin_amdgcn_s_sleep(1); \
    if ((++_sp & 255u) == 0u) { if (xb_ld(&(bar)[XB_TMO])) break; if (_sp > XB_SPIN_CAP) { atomicAdd(&(bar)[XB_TMO], 1u); break; } } } } while (0)

struct XcdBarrier {
    unsigned* bar; unsigned x;
    volatile LAS unsigned* st;
};

__device__ __forceinline__ XcdBarrier xcd_barrier_post(unsigned* bar, volatile LAS unsigned* st) {
    XcdBarrier b; b.bar = bar; b.x = xb_xcc_id(); b.st = st;
    if (threadIdx.x == 0) (void)xb_add(&bar[XB_XCNT(b.x)], 1u);
    return b;
}
__device__ __forceinline__ void xcd_barrier_complete(unsigned* bar, unsigned x, unsigned& nloc, unsigned& nx) {
    const unsigned G = gridDim.x * gridDim.y * gridDim.z;
    unsigned sum, cnt, mine, sp = 0u;
    for (;;) {
        sum = 0u; cnt = 0u; mine = 0u;
#pragma unroll
        for (unsigned j = 0; j < 16; ++j) { const unsigned c = xb_ld(&bar[XB_XCNT(j)]); sum += c; cnt += (c > 0u) ? 1u : 0u; mine = (j == x) ? c : mine; }
        if (sum == G) break;
        __builtin_amdgcn_s_sleep(1);
        if ((++sp & 255u) == 0u) { if (xb_ld(&bar[XB_TMO])) break; if (sp > XB_SPIN_CAP) { atomicAdd(&bar[XB_TMO], 1u); break; } }
    }
    nloc = mine > 0u ? mine : 1u; nx = cnt > 0u ? cnt : 1u;
}

__device__ __forceinline__ void xcd_barrier(const XcdBarrier& b) {
    asm volatile("s_waitcnt vmcnt(0)" ::: "memory");
    __syncthreads();
    if (threadIdx.x == 0) {
        unsigned* bar = b.bar;
        __builtin_amdgcn_s_waitcnt(0);
        unsigned nloc = b.st[0], nx = b.st[1];
        if (nloc == 0u) { xcd_barrier_complete(bar, b.x, nloc, nx); b.st[0] = nloc; b.st[1] = nx; }
        const unsigned old = xb_add(&bar[XB_XSUB(b.x)], 1u);
        const unsigned gen = old / nloc;
        if (old + 1u == (gen + 1u) * nloc) {
            __builtin_amdgcn_fence(__ATOMIC_RELEASE, "agent");
            asm volatile("s_waitcnt vmcnt(0)" ::: "memory");
            const unsigned og = xb_add(&bar[XB_TOP], 1u);
            const unsigned tg = og / nx;
            if (og + 1u == (tg + 1u) * nx) xb_add(&bar[XB_TOPGEN], 1u);
            else XB_SPIN(xb_ld(&bar[XB_TOPGEN]) == tg, bar);
            __builtin_amdgcn_fence(__ATOMIC_ACQUIRE, "agent");
            xb_add(&bar[XB_XGEN(b.x)], 1u);
            asm volatile("s_waitcnt vmcnt(0)" ::: "memory");
        } else {
            XB_SPIN(xb_ld(&bar[XB_XGEN(b.x)]) == gen, bar);
            __builtin_amdgcn_fence(__ATOMIC_ACQUIRE, "agent");
            asm volatile("s_waitcnt vmcnt(0)" ::: "memory");
        }
    }
    __syncthreads();
}

struct TOrder { int c2;
    __device__ __forceinline__ bool next(int i, pg8::Unit& u) const { if (i >= 2) return false; const int idx = c2 + i; u.pm = idx >> 2; u.pn = idx & 3; return true; }
    __device__ __forceinline__ void a_ready(const pg8::Unit&) const {}
    __device__ __forceinline__ void done(const pg8::Unit&) const {} };
#define LAUNDER_S(p) asm volatile("" : "+s"(p))
#define PHASE_PTRS unsigned char* wsl = args.ws; LAUNDER_S(wsl); float* outl = args.out; LAUNDER_S(outl); unsigned* ctl = (unsigned*)(wsl + WS_CTL); (void)ctl; (void)outl; \
    bf16* xn_in = (bf16*)(wsl + ((L & 1) ? WS_XNB : WS_XNA)); bf16* xn_mid = (bf16*)(wsl + ((L & 1) ? WS_XNA : WS_XNB)); (void)xn_in; (void)xn_mid
__global__ void __launch_bounds__(NWAVES * 64, 2) hymba_fwd(Args args) {
    extern __shared__ __attribute__((aligned(16))) unsigned char lds_raw[];
    LAS unsigned char* lds = (LAS unsigned char*)lds_raw;
    cg::grid_group grid = cg::this_grid();
    volatile LAS unsigned* MISC = (volatile LAS unsigned*)(lds + RING_BYTES + 256);
    if (threadIdx.x < 16) MISC[threadIdx.x] = 0u;
    __syncthreads();
    unsigned* barw = (unsigned*)(args.ws + WS_CTL) + CW_BAR; LAUNDER_S(barw);
    const XcdBarrier bar = xcd_barrier_post(barw, MISC + 8);
    if (args.ws == nullptr) grid.sync();
#define GRID_SYNC() xcd_barrier(bar)
    const int G = gridDim.x, bx = blockIdx.x; const int vcu = (G % 8 == 0) ? (bx % 8) * (G / 8) + bx / 8 : bx;

#ifndef NO_PRO
    { int tid_l = threadIdx.x; asm volatile("" : "+v"(tid_l)); const int lane = tid_l & 63; const int wave = __builtin_amdgcn_readfirstlane(tid_l >> 6);
      for (int rep = 0; rep < REP_PRO; ++rep) { p0_prologue(args, lds, vcu, G, wave, lane); if (rep + 1 < REP_PRO) GRID_SYNC(); } }
#endif
    GRID_SYNC();

#pragma unroll 1
    for (int L = 0; L < DEPTH; ++L) {
#if (PHASES & 1)
        {   PHASE_PTRS;
            pg8::Gemm g{xn_in, (const bf16*)(wsl + WS_WIN) + (size_t)L * D_IN * DM, M, D_IN, DM}; pg8::StaticOrder S; S.init(M, D_IN, G, bx);
            pg8::EpiIn E{(bf16*)(wsl + WS_Q), (bf16*)(wsl + WS_K), (bf16*)(wsl + WS_V), (bf16*)(wsl + WS_GU), (bf16*)(wsl + WS_GV), 0.125f * LOG2E};
            for (int rep = 0; rep < REP_P1; ++rep) pg8::gemm_phase<pg8::EpiIn, pg8::StaticOrder, PG8_ALIGN, PG8_SP2>(lds, g, S, E); }
#endif
        if (bx >= 192) { int tid_l = threadIdx.x; asm volatile("" : "+v"(tid_l)); const int lane = tid_l & 63; const int wave = __builtin_amdgcn_readfirstlane(tid_l >> 6);
            const int gw = (bx - 192) * NWAVES + wave, NGW = 64 * NWAVES;
            if (L + 1 < DEPTH) conv_weights(args, L + 1, L + 2, gw, NGW, lane, 1);
            conv_p(args, L, gw * 64 + lane, NGW * 64); }
        GRID_SYNC();
#ifndef NO_ATTN
        {   PHASE_PTRS;
            for (int rep = 0; rep < REP_ATTN; ++rep) for (int u = vcu; u < 256; u += G) attn_unit(u >> 7, u & 127, (const bf16*)(wsl + WS_Q), (const bf16*)(wsl + WS_K), (const bf16*)(wsl + WS_V), (bf16*)(wsl + WS_HEADS), args.in[4] + L * 8, lds); }
#endif
#ifndef NO_GATE
        {   PHASE_PTRS;
            for (int rep = 0; rep < REP_GATE; ++rep) for (int u = vcu; u < 256; u += G) gate_unit(u >> 7, (u & 127) >> 1, u & 1, (const bf16*)(wsl + WS_GU), (const bf16*)(wsl + WS_GV), (bf16*)(wsl + WS_HEADS), (const bf16*)(wsl + WS_WTRIL) + (size_t)L * 8 * 128 * 128,
                                                          args.in[5] + L * GM_W, args.in[6] + L * GM_W, args.in[8] + L * 8 * 128, lds); }
#endif
        GRID_SYNC();
#if (PHASES & 2)
        {   PHASE_PTRS;
            pg8::Gemm g{(const bf16*)(wsl + WS_HEADS), (const bf16*)(wsl + WS_WOUT) + (size_t)L * DM * DM, M, DM, DM}; pg8::StaticOrder S; S.init(M, DM, G, bx);
            const int e0 = L * 5;
            pg8::RmsStats st1{(unsigned*)(wsl + WS_X + (size_t)(e0 + 0) * XBANK_BYTES), ctl + CW_SEAM + (e0 + 0) * SEAM_BANK, NORM_EPS};
            pg8::RmsStats st2{(unsigned*)(wsl + WS_X + (size_t)(e0 + 1) * XBANK_BYTES), ctl + CW_SEAM + (e0 + 1) * SEAM_BANK, NORM_EPS};
            const float* base = (L == 0) ? args.in[0] : (const float*)outl;
#ifdef PROBE_XCHG
            pg8::RmsStats st3{(unsigned*)(wsl + WS_X + (size_t)(20 + 2 * L) * XBANK_BYTES), ctl + CW_SEAM + (20 + 2 * L) * SEAM_BANK, NORM_EPS};
            pg8::EpiRmsResRms E{base, outl, xn_mid, DM, args.in[12] + L * DM, st1, st2, st3};
#else
            pg8::EpiRmsResRms E{base, outl, xn_mid, DM, args.in[12] + L * DM, st1, st2};
#endif
            pg8::gemm_phase<pg8::EpiRmsResRms, pg8::StaticOrder, false, PG8_SP2>(lds, g, S, E); }
#endif
        GRID_SYNC();
#if (PHASES & 4)
        {   PHASE_PTRS;
            pg8::Gemm g{xn_mid, (const bf16*)(wsl + WS_WGU) + (size_t)L * 2 * D_FF * DM, M, 2 * D_FF, DM}; pg8::StaticOrder S; S.init(M, 2 * D_FF, G, bx);
            pg8::EpiSwiGLU E{(bf16*)(wsl + WS_HID), D_FF};
            for (int rep = 0; rep < REP_P4; ++rep) pg8::gemm_phase<pg8::EpiSwiGLU, pg8::StaticOrder, PG8_ALIGN, PG8_SP2>(lds, g, S, E); }
#endif
        if (bx >= 128) { PHASE_PTRS; __syncthreads();
            pg8::Gemm g{(const bf16*)(wsl + WS_PB) + (size_t)L * M * PLE, (const bf16*)(wsl + WS_WP) + (size_t)L * DM * PLE, M, DM, PLE}; TOrder S{(bx - 128) * 2};
            pg8::EpiPlain E{(bf16*)(wsl + WS_T), DM};
            pg8::gemm_phase<pg8::EpiPlain, TOrder, PG8_ALIGN, PG8_SP2>(lds, g, S, E); }
        GRID_SYNC();
#if (PHASES & 8)
        {   PHASE_PTRS;
            pg8::Gemm g{(const bf16*)(wsl + WS_HID), (const bf16*)(wsl + WS_WD) + (size_t)L * DM * D_FF, M, DM, D_FF}; pg8::StaticOrder S; S.init(M, DM, G, bx);
            const int e0 = L * 5 + 2;
            pg8::RmsStats st1{(unsigned*)(wsl + WS_X + (size_t)(e0 + 0) * XBANK_BYTES), ctl + CW_SEAM + (e0 + 0) * SEAM_BANK, NORM_EPS};
            pg8::RmsStats st2{(unsigned*)(wsl + WS_X + (size_t)(e0 + 1) * XBANK_BYTES), ctl + CW_SEAM + (e0 + 1) * SEAM_BANK, NORM_EPS};
#ifdef PROBE_XCHG
            pg8::RmsStats st3{(unsigned*)(wsl + WS_X + (size_t)(21 + 2 * L) * XBANK_BYTES), ctl + CW_SEAM + (21 + 2 * L) * SEAM_BANK, NORM_EPS};
            pg8::EpiRmsResRms E{(const float*)outl, outl, xn_in, DM, args.in[17] + L * DM, st1, st2, st3};
#else
            pg8::EpiRmsResRms E{(const float*)outl, outl, xn_in, DM, args.in[17] + L * DM, st1, st2};
#endif
            pg8::gemm_phase<pg8::EpiRmsResRms, pg8::StaticOrder, false, PG8_SP2>(lds, g, S, E); }
#endif
        GRID_SYNC();
#if (PHASES & 32)
        {   PHASE_PTRS;
            pg8::Gemm g{xn_in, (const bf16*)(wsl + WS_WPG) + (size_t)L * DM * DM, M, DM, DM}; pg8::StaticOrder S; S.init(M, DM, G, bx);
            pg8::RmsStats st{(unsigned*)(wsl + WS_X + (size_t)(L * 5 + 4) * XBANK_BYTES), ctl + CW_SEAM + (L * 5 + 4) * SEAM_BANK, NORM_EPS};
            if (L < DEPTH - 1) { pg8::EpiPle<false> E{(const float*)outl, outl, xn_mid, (const bf16*)(wsl + WS_T), DM, st};
                pg8::gemm_phase<pg8::EpiPle<false>, pg8::StaticOrder, false, PG8_SP2>(lds, g, S, E); }
            else { pg8::EpiPle<true> E{(const float*)outl, outl, xn_mid, (const bf16*)(wsl + WS_T), DM, st};
                pg8::gemm_phase<pg8::EpiPle<true>, pg8::StaticOrder, false, PG8_SP2>(lds, g, S, E); } }
#endif
        for (int rep = 0; rep < EXTRA_SYNC; ++rep) GRID_SYNC();
        if (L < DEPTH - 1) GRID_SYNC();
    }
}

extern "C" void kernel_launch(void* const* d_in, const int* in_sizes, int n_in, void* d_out, int out_size, void* d_ws, size_t ws_size, hipStream_t stream) {
    static int grid = 0;
    if (grid == 0) {
        if (n_in != 21 || in_sizes[0] != M * DM || out_size != M * DM || ws_size < WS_END) { fprintf(stderr, "kernel_launch: shape/workspace mismatch (n_in %d, in0 %d, out %d, ws %zu need %zu)\n", n_in, n_in > 0 ? in_sizes[0] : -1, out_size, ws_size, (size_t)WS_END); grid = -1; return; }
        int dev = 0, cus = 0, per_cu = 0;
        if (hipGetDevice(&dev) != hipSuccess || hipDeviceGetAttribute(&cus, hipDeviceAttributeMultiprocessorCount, dev) != hipSuccess) { grid = -1; return; }
        if (hipFuncSetAttribute((const void*)hymba_fwd, hipFuncAttributeMaxDynamicSharedMemorySize, LDS_BYTES) != hipSuccess) { fprintf(stderr, "kernel_launch: hipFuncSetAttribute failed\n"); grid = -1; return; }
        if (hipOccupancyMaxActiveBlocksPerMultiprocessor(&per_cu, (const void*)hymba_fwd, NWAVES * 64, LDS_BYTES) != hipSuccess || per_cu < 1) { fprintf(stderr, "kernel_launch: occupancy query says %d\n", per_cu); per_cu = 1; }
        (void)hipGetLastError();
        grid = cus;
        if (grid != 256) fprintf(stderr, "kernel_launch: %d CUs; the fused epilogues need exactly 256 workgroups\n", grid);
    }
    if (grid < 0) return;
    if (hipMemsetAsync((char*)d_ws + WS_CTL, 0, CTL_ZERO_BYTES, stream) != hipSuccess) { fprintf(stderr, "kernel_launch: memset failed\n"); return; }
    Args a{};
    for (int i = 0; i < 21; ++i) a.in[i] = (const float*)d_in[i];
    a.out = (float*)d_out; a.ws = (unsigned char*)d_ws;
    void* kargs[] = {&a};
    hipError_t e = hipLaunchCooperativeKernel((const void*)hymba_fwd, dim3(grid), dim3(NWAVES * 64), kargs, LDS_BYTES, stream);
    if (e != hipSuccess) fprintf(stderr, "cooperative launch failed: %s (grid %d)\n", hipGetErrorString(e), grid);
}
```
